# Optimizing an MI355X kernel written in HIP

```python
import math
import jax
import jax.numpy as jnp
from jax import lax
import numpy as np

D_MODEL = 2048
BATCH = 4
SEQ = 4096
DEPTH = 2

HEAD_DIM = 128
N_A = DEPTH // 2
N_B = DEPTH - N_A
N_HEADS_A = 12
N_KV_A = 2
HPG_A = N_HEADS_A // N_KV_A
CMP_LEN = 32
CMP_STRIDE = 16
CMP_HIDDEN = 256
SLC_BLK = 64
N_SEL = 16
WIN_A = 512
Q_BLK_A = 64
DIL_CONFIGS = ((128, 1), (512, 4), (2048, 16))
N_DIL_GROUPS = len(DIL_CONFIGS)
DIL_HEADS = 4
N_KV_B = DIL_HEADS
Q_BLK_B = 128
N_MEM = 256
N_MEM_HEADS = 4
D_FF = -(-(8 * D_MODEL) // (3 * 256)) * 256
ROPE_THETA = 10000.0
EPS = 1e-6
NEG_INF = -1e30
TINY = 1e-30

A_Q = N_HEADS_A * HEAD_DIM
A_KV = 6 * N_KV_A * HEAD_DIM
A_GATE = 3 * N_HEADS_A
MEM_Q = N_MEM_HEADS * HEAD_DIM
A_IN = A_Q + A_KV + A_GATE + MEM_Q
A_OUT_IN = A_Q + MEM_Q
B_Q = N_DIL_GROUPS * DIL_HEADS * HEAD_DIM
B_IN = B_Q + MEM_Q
B_OUT_IN = DIL_HEADS * HEAD_DIM + MEM_Q

kernel_name = "yoco_nsa_dilated_mem_swiglu"


def rms_norm(x, g):
    x32 = x.astype(jnp.float32)
    y = x32 * lax.rsqrt(jnp.mean(x32 * x32, axis=-1, keepdims=True) + EPS)
    return (y * g.astype(jnp.float32)).astype(x.dtype)


def rope_tables(seq):
    inv = 1.0 / (ROPE_THETA ** (jnp.arange(0, HEAD_DIM, 2, dtype=jnp.float32) / HEAD_DIM))
    ang = jnp.arange(seq, dtype=jnp.float32)[:, None] * inv[None, :]
    return jnp.cos(ang), jnp.sin(ang)


def apply_rope(x, cos, sin):
    x32 = x.astype(jnp.float32)
    x1, x2 = jnp.split(x32, 2, axis=-1)
    c = cos[None, :, None, :]
    s = sin[None, :, None, :]
    return jnp.concatenate([x1 * c - x2 * s, x2 * c + x1 * s], axis=-1).astype(x.dtype)


def masked_probs(s, mask):
    s = jnp.where(mask, s, NEG_INF)
    m = jnp.max(s, axis=-1, keepdims=True)
    e = jnp.where(mask, jnp.exp(s - m), 0.0)
    den = jnp.sum(e, axis=-1, keepdims=True)
    return e / jnp.maximum(den, TINY), m + jnp.log(jnp.maximum(den, TINY))


def swiglu(h, w_gate, w_up, w_down):
    return (jax.nn.silu(h @ w_gate) * (h @ w_up)) @ w_down


def compress(x_raw, pe, w1, w2):
    b, s, g, d = x_raw.shape
    n_cmp = (s - CMP_LEN) // CMP_STRIDE + 1
    idx = np.arange(n_cmp)[:, None] * CMP_STRIDE + np.arange(CMP_LEN)[None, :]
    blocks = x_raw[:, idx] + pe[None, None, :, None, :].astype(x_raw.dtype)
    blocks = jnp.transpose(blocks, (0, 1, 3, 2, 4)).reshape(b, n_cmp, g, CMP_LEN * d)
    return jax.nn.silu(blocks @ w1) @ w2


def cmp_to_slc_matrix(seq):
    n_cmp = (seq - CMP_LEN) // CMP_STRIDE + 1
    n_slc = seq // SLC_BLK
    c0 = np.arange(n_cmp) * CMP_STRIDE
    s0 = np.arange(n_slc) * SLC_BLK
    ov = (c0[None, :] < s0[:, None] + SLC_BLK) & (c0[None, :] + CMP_LEN > s0[:, None])
    return jnp.asarray(ov.astype(np.float32))


def nsa_attention(q, k_cmp_raw, v_cmp_raw, k_slc, v_slc, k_win, v_win, gates,
                  pe_k, w1_k, w2_k, pe_v, w1_v, w2_v):
    b, s, h, d = q.shape
    g = N_KV_A
    scale = HEAD_DIM ** -0.5
    kc = compress(k_cmp_raw, pe_k, w1_k, w2_k)
    vc = compress(v_cmp_raw, pe_v, w1_v, w2_v)
    n_cmp = kc.shape[1]
    cmp_end = jnp.arange(n_cmp) * CMP_STRIDE + CMP_LEN - 1
    n_slc = s // SLC_BLK
    n_top = min(N_SEL, n_slc)
    m_map = cmp_to_slc_matrix(s)
    kb = k_slc.reshape(b, n_slc, SLC_BLK, g, d).transpose(0, 3, 1, 2, 4)
    vb = v_slc.reshape(b, n_slc, SLC_BLK, g, d).transpose(0, 3, 1, 2, 4)
    kw = jnp.pad(k_win, ((0, 0), (WIN_A, 0), (0, 0), (0, 0)))
    vw = jnp.pad(v_win, ((0, 0), (WIN_A, 0), (0, 0), (0, 0)))
    qg = q.reshape(b, s, g, HPG_A, d)
    gg = gates.reshape(b, s, g, HPG_A, 3)
    bi = jnp.arange(b)[:, None, None, None]
    gi = jnp.arange(g)[None, :, None, None]
    j_blk = jnp.arange(n_slc)
    lb = jnp.arange(SLC_BLK)

    def block(i):
        s0 = i * Q_BLK_A
        t = s0 + jnp.arange(Q_BLK_A)
        qb = lax.dynamic_slice_in_dim(qg, s0, Q_BLK_A, axis=1)
        gb = lax.dynamic_slice_in_dim(gg, s0, Q_BLK_A, axis=1)
        sc = jnp.einsum('bqgpd,bcgd->bgpqc', qb, kc).astype(jnp.float32) * scale
        p_cmp, _ = masked_probs(sc, cmp_end[None, :] <= t[:, None])
        o_cmp = jnp.einsum('bgpqc,bcgd->bqgpd', p_cmp.astype(vc.dtype), vc)
        imp = jnp.einsum('bgpqc,sc->bgqs', p_cmp, m_map)
        cur = t // SLC_BLK
        forced = (j_blk[None] == 0) | (j_blk[None] == cur[:, None]) | (j_blk[None] == cur[:, None] - 1)
        eligible = j_blk[None] * SLC_BLK <= t[:, None]
        score = jnp.where(forced, 1e9, jnp.where(eligible, imp, -1e9))
        _, sel = lax.top_k(score, n_top)
        ks = kb[bi, gi, sel]
        vs = vb[bi, gi, sel]
        ss = jnp.einsum('bqgpd,bgqnkd->bgpqnk', qb, ks).astype(jnp.float32) * scale
        ss = ss.reshape(b, g, HPG_A, Q_BLK_A, n_top * SLC_BLK)
        tok = sel[..., None] * SLC_BLK + lb
        smask = (tok <= t[None, None, :, None, None]).reshape(b, g, 1, Q_BLK_A, n_top * SLC_BLK)
        p_slc, _ = masked_probs(ss, smask)
        o_slc = jnp.einsum('bgpqm,bgqmd->bqgpd', p_slc.astype(vs.dtype),
                           vs.reshape(b, g, Q_BLK_A, n_top * SLC_BLK, d))
        kwb = lax.dynamic_slice_in_dim(kw, s0, Q_BLK_A + WIN_A, axis=1)
        vwb = lax.dynamic_slice_in_dim(vw, s0, Q_BLK_A + WIN_A, axis=1)
        pos = s0 - WIN_A + jnp.arange(Q_BLK_A + WIN_A)
        dist = t[:, None] - pos[None, :]
        wmask = (dist >= 0) & (dist < WIN_A) & (pos[None, :] >= 0)
        sw = jnp.einsum('bqgpd,bkgd->bgpqk', qb, kwb).astype(jnp.float32) * scale
        p_win, _ = masked_probs(sw, wmask)
        o_win = jnp.einsum('bgpqk,bkgd->bqgpd', p_win.astype(vwb.dtype), vwb)
        o = gb[..., 0:1] * o_cmp + gb[..., 1:2] * o_slc + gb[..., 2:3] * o_win
        return o.reshape(b, Q_BLK_A, h, d)

    out = lax.map(block, jnp.arange(s // Q_BLK_A))
    return jnp.transpose(out, (1, 0, 2, 3, 4)).reshape(b, s, h, d)


def dilated_attention(q, k, v):
    b, s, _, hg, d = q.shape
    scale = HEAD_DIM ** -0.5

    def block(i):
        s0 = i * Q_BLK_B
        t = s0 + jnp.arange(Q_BLK_B)
        qb = lax.dynamic_slice_in_dim(q, s0, Q_BLK_B, axis=1)
        outs, lses = [], []
        for gidx, (w, r) in enumerate(DIL_CONFIGS):
            n_k = w // r + 1
            pos = t[:, None] - r * jnp.arange(n_k)[None, :]
            valid = pos >= 0
            posc = jnp.maximum(pos, 0)
            kg = k[:, posc]
            vg = v[:, posc]
            sg = jnp.einsum('bqhd,bqkhd->bhqk', qb[:, :, gidx], kg).astype(jnp.float32) * scale
            p, lse = masked_probs(sg, valid[None, None])
            og = jnp.einsum('bhqk,bqkhd->bhqd', p.astype(vg.dtype), vg)
            outs.append(og.astype(jnp.float32))
            lses.append(lse[..., 0])
        alpha = jax.nn.softmax(jnp.stack(lses, 0), axis=0)
        o = jnp.sum(alpha[..., None] * jnp.stack(outs, 0), axis=0)
        return jnp.transpose(o, (0, 2, 1, 3)).astype(q.dtype)

    out = lax.map(block, jnp.arange(s // Q_BLK_B))
    return jnp.transpose(out, (1, 0, 2, 3, 4)).reshape(b, s, hg, d)


def memory_attention(qm, mem, norm_mem, w_mem_kv):
    b, m, _ = mem.shape
    mkv = (rms_norm(mem, norm_mem) @ w_mem_kv).reshape(b, m, 2, N_MEM_HEADS, HEAD_DIM)
    mk, mv = mkv[:, :, 0], mkv[:, :, 1]
    sm = jnp.einsum('bshd,bmhd->bhsm', qm, mk).astype(jnp.float32) * (HEAD_DIM ** -0.5)
    p = jax.nn.softmax(sm, axis=-1)
    return jnp.einsum('bhsm,bmhd->bshd', p.astype(mv.dtype), mv)


def layer_a(h, mem, cos, sin, norm_attn, w_in, gate_bias, pe_k, w1_k, w2_k, pe_v, w1_v, w2_v,
            norm_mem, w_mem_kv, w_out, norm_ffn, w_gate, w_up, w_down):
    b, s, _ = h.shape
    z = rms_norm(h, norm_attn) @ w_in
    zq, zkv, zg, zm = jnp.split(z, [A_Q, A_Q + A_KV, A_Q + A_KV + A_GATE], axis=-1)
    q = apply_rope(zq.reshape(b, s, N_HEADS_A, HEAD_DIM), cos, sin)
    kv = zkv.reshape(b, s, 6, N_KV_A, HEAD_DIM)
    k_cmp = apply_rope(kv[:, :, 0], cos, sin)
    k_slc = apply_rope(kv[:, :, 2], cos, sin)
    k_win = apply_rope(kv[:, :, 4], cos, sin)
    gates = jax.nn.sigmoid(zg + gate_bias).reshape(b, s, N_HEADS_A, 3)
    o_nsa = nsa_attention(q, k_cmp, kv[:, :, 1], k_slc, kv[:, :, 3], k_win, kv[:, :, 5], gates,
                          pe_k, w1_k, w2_k, pe_v, w1_v, w2_v)
    o_mem = memory_attention(zm.reshape(b, s, N_MEM_HEADS, HEAD_DIM), mem, norm_mem, w_mem_kv)
    o = jnp.concatenate([o_nsa.reshape(b, s, A_Q), o_mem.reshape(b, s, MEM_Q)], axis=-1) @ w_out
    h = h + o
    return h + swiglu(rms_norm(h, norm_ffn), w_gate, w_up, w_down)


def layer_b(h, mem, cos, sin, k_sh, v_sh, norm_attn, w_in, norm_mem, w_mem_kv, w_out,
            norm_ffn, w_gate, w_up, w_down):
    b, s, _ = h.shape
    z = rms_norm(h, norm_attn) @ w_in
    zq, zm = jnp.split(z, [B_Q], axis=-1)
    q = apply_rope(zq.reshape(b, s, N_DIL_GROUPS * DIL_HEADS, HEAD_DIM), cos, sin)
    q = q.reshape(b, s, N_DIL_GROUPS, DIL_HEADS, HEAD_DIM)
    o_dil = dilated_attention(q, k_sh, v_sh)
    o_mem = memory_attention(zm.reshape(b, s, N_MEM_HEADS, HEAD_DIM), mem, norm_mem, w_mem_kv)
    o = jnp.concatenate([o_dil.reshape(b, s, DIL_HEADS * HEAD_DIM),
                         o_mem.reshape(b, s, MEM_Q)], axis=-1) @ w_out
    h = h + o
    return h + swiglu(rms_norm(h, norm_ffn), w_gate, w_up, w_down)


def setup_inputs(seed: int = 0) -> dict:
    key = jax.random.key(seed)
    ks = jax.random.split(key, 40)
    f32 = jnp.float32

    def w(k, shape, fan_in):
        return jax.random.normal(k, shape, f32) * (fan_in ** -0.5)

    def gain(k, shape):
        return 1.0 + 0.02 * jax.random.normal(k, shape, f32)

    return {
        "x": jax.random.normal(ks[0], (BATCH, SEQ, D_MODEL), f32),
        "mem": jax.random.normal(ks[1], (BATCH, N_MEM, D_MODEL), f32),
        "a_norm_attn": gain(ks[2], (N_A, D_MODEL)),
        "a_w_in": w(ks[3], (N_A, D_MODEL, A_IN), D_MODEL),
        "a_gate_bias": 0.01 * jax.random.normal(ks[4], (N_A, A_GATE), f32),
        "a_cmp_pe_k": 0.1 * jax.random.normal(ks[5], (N_A, CMP_LEN, HEAD_DIM), f32),
        "a_cmp_w1_k": w(ks[6], (N_A, CMP_LEN * HEAD_DIM, CMP_HIDDEN), CMP_LEN * HEAD_DIM),
        "a_cmp_w2_k": w(ks[7], (N_A, CMP_HIDDEN, HEAD_DIM), CMP_HIDDEN),
        "a_cmp_pe_v": 0.1 * jax.random.normal(ks[8], (N_A, CMP_LEN, HEAD_DIM), f32),
        "a_cmp_w1_v": w(ks[9], (N_A, CMP_LEN * HEAD_DIM, CMP_HIDDEN), CMP_LEN * HEAD_DIM),
        "a_cmp_w2_v": w(ks[10], (N_A, CMP_HIDDEN, HEAD_DIM), CMP_HIDDEN),
        "a_norm_mem": gain(ks[11], (N_A, D_MODEL)),
        "a_w_mem_kv": w(ks[12], (N_A, D_MODEL, 2 * MEM_Q), D_MODEL),
        "a_w_out": w(ks[13], (N_A, A_OUT_IN, D_MODEL), A_OUT_IN),
        "a_norm_ffn": gain(ks[14], (N_A, D_MODEL)),
        "a_w_gate": w(ks[15], (N_A, D_MODEL, D_FF), D_MODEL),
        "a_w_up": w(ks[16], (N_A, D_MODEL, D_FF), D_MODEL),
        "a_w_down": w(ks[17], (N_A, D_FF, D_MODEL), D_FF),
        "kv_norm": gain(ks[18], (D_MODEL,)),
        "w_kv_shared": w(ks[19], (D_MODEL, 2 * N_KV_B * HEAD_DIM), D_MODEL),
        "b_norm_attn": gain(ks[20], (N_B, D_MODEL)),
        "b_w_in": w(ks[21], (N_B, D_MODEL, B_IN), D_MODEL),
        "b_norm_mem": gain(ks[22], (N_B, D_MODEL)),
        "b_w_mem_kv": w(ks[23], (N_B, D_MODEL, 2 * MEM_Q), D_MODEL),
        "b_w_out": w(ks[24], (N_B, B_OUT_IN, D_MODEL), B_OUT_IN),
        "b_norm_ffn": gain(ks[25], (N_B, D_MODEL)),
        "b_w_gate": w(ks[26], (N_B, D_MODEL, D_FF), D_MODEL),
        "b_w_up": w(ks[27], (N_B, D_MODEL, D_FF), D_MODEL),
        "b_w_down": w(ks[28], (N_B, D_FF, D_MODEL), D_FF),
        "final_norm": gain(ks[29], (D_MODEL,)),
    }


def reference(x, mem, a_norm_attn, a_w_in, a_gate_bias, a_cmp_pe_k, a_cmp_w1_k, a_cmp_w2_k,
              a_cmp_pe_v, a_cmp_w1_v, a_cmp_w2_v, a_norm_mem, a_w_mem_kv, a_w_out, a_norm_ffn,
              a_w_gate, a_w_up, a_w_down, kv_norm, w_kv_shared, b_norm_attn, b_w_in,
              b_norm_mem, b_w_mem_kv, b_w_out, b_norm_ffn, b_w_gate, b_w_up, b_w_down,
              final_norm):
    b, s, _ = x.shape
    cos, sin = rope_tables(s)
    h = x
    k_sh = v_sh = None
    for layer in range(DEPTH):
        if layer < N_A:
            l = layer
            h = layer_a(h, mem, cos, sin, a_norm_attn[l], a_w_in[l], a_gate_bias[l],
                        a_cmp_pe_k[l], a_cmp_w1_k[l], a_cmp_w2_k[l],
                        a_cmp_pe_v[l], a_cmp_w1_v[l], a_cmp_w2_v[l],
                        a_norm_mem[l], a_w_mem_kv[l], a_w_out[l], a_norm_ffn[l],
                        a_w_gate[l], a_w_up[l], a_w_down[l])
        else:
            if layer == N_A:
                kv = (rms_norm(h, kv_norm) @ w_kv_shared).reshape(b, s, 2, N_KV_B, HEAD_DIM)
                k_sh = apply_rope(kv[:, :, 0], cos, sin)
                v_sh = kv[:, :, 1]
            l = layer - N_A
            h = layer_b(h, mem, cos, sin, k_sh, v_sh, b_norm_attn[l], b_w_in[l], b_norm_mem[l],
                        b_w_mem_kv[l], b_w_out[l], b_norm_ffn[l], b_w_gate[l], b_w_up[l],
                        b_w_down[l])
    return rms_norm(h, final_norm)
```

```cpp
#include <hip/hip_runtime.h>
#include <hip/hip_cooperative_groups.h>
#include <cstdio>
#include <cstdint>
namespace cg = cooperative_groups;
#ifndef N_LAUNCH_MODE
#define N_LAUNCH_MODE 1
#endif
namespace pg8 {
#define PG8_LAS __attribute__((address_space(3)))
typedef unsigned short bf16_t;
typedef short bf16x8 __attribute__((ext_vector_type(8)));
typedef float f32x4 __attribute__((ext_vector_type(4)));
typedef unsigned u32x4 __attribute__((ext_vector_type(4)));
constexpr int BM = 256, BK = 64, HALF = 128, HTB = HALF * BK * 2  , STAGE_BYTES = 8 * HTB, NXCD = 8, WGM = 8;

__host__ __device__ __forceinline__ int lds_byte(int r, int c) { const int st = (r >> 4) * 2 + (c >> 5), rr = r & 15, cc = c & 31, ob = rr * 64 + cc * 2; return st * 1024 + (ob ^ (((ob >> 9) & 1) << 5)); }
__host__ __device__ __forceinline__ void stage_rc(int b, int& R, int& C) { const int st = b / 1024, sb = b % 1024, swz = sb ^ (((sb >> 9) & 1) << 5); R = (st >> 1) * 16 + swz / 64; C = (st & 1) * 32 + (swz % 64) / 2; }
__host__ __device__ __forceinline__ int perm32(int rho) { const int n = rho >> 4, i = rho & 15; return 8 * (i >> 2) + 4 * n + (i & 3); }

struct Unit { int pm, pn; };
struct Gemm { const bf16_t* A; const bf16_t* Bt; int M, N, K; };

struct StaticOrder {
    int nM, nN, nwg, G, c;
    __host__ __device__ void init(int M, int N, int G_, int c_) { nM = M / BM; nN = N / BM; nwg = nM * nN; G = G_; c = c_; }
    __host__ __device__ bool next(int i, Unit& u) const {
        const long L = (long)i * G + c; if (L >= nwg) return false;
        int wgid = (int)L; { const int q = nwg / NXCD, r = nwg % NXCD, xcd = wgid % NXCD, off = wgid / NXCD; wgid = (xcd < r ? xcd * (q + 1) : r * (q + 1) + (xcd - r) * q) + off; }
        const int nig = WGM * nN, gid = wgid / nig, fm = gid * WGM, gsz = (nM - fm) < WGM ? (nM - fm) : WGM;
        u.pm = fm + ((wgid % nig) % gsz); u.pn = (wgid % nig) / gsz; return true;
    }
    __device__ __forceinline__ void a_ready(const Unit&) const {}
    __device__ __forceinline__ void done(const Unit&) const {}
};

typedef float f32x2c_t __attribute__((ext_vector_type(2))); typedef __bf16 bf16x2c_t __attribute__((ext_vector_type(2)));
__device__ __forceinline__ unsigned cvt_pk_bf16(float lo, float hi) { f32x2c_t v = {lo, hi}; bf16x2c_t b = __builtin_convertvector(v, bf16x2c_t); return __builtin_bit_cast(unsigned, b); }
typedef unsigned u32x2 __attribute__((ext_vector_type(2)));
enum { EM_INA = 0, EM_INB = 1, EM_MEMKV = 2, EM_RES = 3, EM_GU = 4 };
constexpr float QSCALE = 0.08838834764831845f * 1.4426950408889634f;
constexpr float EPSN = 1e-6f;
struct EpiG {
    static constexpr bool PERM = true, AFTER_DRAIN = false;
    int mode;
    const float* ss; const unsigned long long* ssq; const float* res; const bf16_t* resb; float* hout; bf16_t* hb; unsigned long long* ssout;
    bf16_t* o0; bf16_t* o1; bf16_t* o2; bf16_t* o3;
    float* gates; const float* gbias; const float* cosT; const float* sinT;
    __device__ __forceinline__ float rowss(size_t row) const { return ssq ? (float)ssq[row] * 5.9604644775390625e-08f : ss[row]; }
    __device__ __forceinline__ void operator()(const f32x4 (&acc)[2][2][4][2], const Unit& u, int wr, int wc, int fr, int fq) const {
        const int rowb = u.pm * BM + wr * 64 + fr;
        const int cl = wc * 32 + 8 * fq;
        if (mode == EM_RES) {
#pragma unroll
            for (int ai = 0; ai < 2; ++ai) {
                u32x4 rw[4][2];
#pragma unroll
                for (int m = 0; m < 4; ++m)
#pragma unroll
                    for (int bj = 0; bj < 2; ++bj) rw[m][bj] = *(const u32x4*)(resb + (size_t)(rowb + ai * HALF + m * 16) * 2048 + (size_t)(u.pn * BM + bj * HALF + cl));
#pragma unroll
                for (int m = 0; m < 4; ++m) {
                    const size_t row = (size_t)(rowb + ai * HALF + m * 16);
                    float sq = 0.f;
#pragma unroll
                    for (int bj = 0; bj < 2; ++bj) {
                        const size_t off = row * 2048 + (size_t)(u.pn * BM + bj * HALF + cl);
                        const u32x4 q = rw[m][bj];
                        const f32x4 r0 = (f32x4){__uint_as_float(q.x << 16), __uint_as_float(q.x & 0xffff0000u), __uint_as_float(q.y << 16), __uint_as_float(q.y & 0xffff0000u)};
                        const f32x4 r1 = (f32x4){__uint_as_float(q.z << 16), __uint_as_float(q.z & 0xffff0000u), __uint_as_float(q.w << 16), __uint_as_float(q.w & 0xffff0000u)};
                        const f32x4 h0 = r0 + acc[ai][bj][m][0], h1 = r1 + acc[ai][bj][m][1];
                        if (hout) { *(f32x4*)(hout + off) = h0; *(f32x4*)(hout + off + 4) = h1; }
                        u32x4 w; w.x = cvt_pk_bf16(h0[0], h0[1]); w.y = cvt_pk_bf16(h0[2], h0[3]); w.z = cvt_pk_bf16(h1[0], h1[1]); w.w = cvt_pk_bf16(h1[2], h1[3]);
                        if (hb) *(u32x4*)(hb + off) = w;
                        sq += (h0[0] * h0[0] + h0[1] * h0[1]) + (h0[2] * h0[2] + h0[3] * h0[3]) + (h1[0] * h1[0] + h1[1] * h1[1]) + (h1[2] * h1[2] + h1[3] * h1[3]);
                    }
                    sq += __shfl_xor(sq, 16); sq += __shfl_xor(sq, 32);
                    if (fq == 0) atomicAdd(ssout + row, (unsigned long long)(sq * 16777216.0f + 0.5f));
                }
            }
            return;
        }
        float rsv[8];
        {
            float ssv[8];
#pragma unroll
            for (int i = 0; i < 8; ++i) ssv[i] = rowss((size_t)(rowb + (i >> 2) * HALF + (i & 3) * 16));
#pragma unroll
            for (int i = 0; i < 8; ++i) rsv[i] = 1.0f / sqrtf(ssv[i] * (1.0f / 2048.0f) + EPSN);
        }
        if (mode == EM_GU) {
#pragma unroll
            for (int ai = 0; ai < 2; ++ai)
#pragma unroll
                for (int m = 0; m < 4; ++m) {
                    const size_t row = (size_t)(rowb + ai * HALF + m * 16);
                    const float rs = rsv[ai * 4 + m];
                    float a[8];
#pragma unroll
                    for (int n = 0; n < 2; ++n)
#pragma unroll
                        for (int j = 0; j < 4; ++j) {
                            const float g = acc[ai][0][m][n][j] * rs, uu = acc[ai][1][m][n][j] * rs;
                            const float sg = g * __builtin_amdgcn_rcpf(1.0f + __builtin_amdgcn_exp2f(-g * 1.4426950408889634f));
                            a[n * 4 + j] = sg * uu;
                        }
                    u32x4 w; w.x = cvt_pk_bf16(a[0], a[1]); w.y = cvt_pk_bf16(a[2], a[3]); w.z = cvt_pk_bf16(a[4], a[5]); w.w = cvt_pk_bf16(a[6], a[7]);
                    *(u32x4*)(o0 + row * 5632 + (size_t)(u.pn * HALF + cl)) = w;
                }
            return;
        }
        bf16_t* dst = o0; int ld = 1536, colbase = 0; bool rope = false, isgate = false; float scale = 1.f;
        const int pn = u.pn;
        if (mode == EM_INA) {
            if (pn < 6) { dst = o0; ld = 1536; colbase = pn * 256; rope = true; scale = QSCALE; }
            else if (pn < 12) { dst = o1; ld = 1536; colbase = (pn - 6) * 256; rope = (((pn - 6) & 1) == 0); }
            else if (pn < 14) { dst = o2; ld = 512; colbase = (pn - 12) * 256; scale = QSCALE; }
            else isgate = true;
        } else if (mode == EM_INB) {
            if (pn < 6) { dst = o0; ld = 1536; colbase = pn * 256; rope = true; scale = QSCALE; }
            else if (pn < 8) { dst = o2; ld = 512; colbase = (pn - 6) * 256; scale = QSCALE; }
            else if (pn < 10) { dst = o1; ld = 512; colbase = (pn - 8) * 256; rope = true; }
            else { dst = o3; ld = 512; colbase = (pn - 10) * 256; }
        } else { dst = o0; ld = 1024; colbase = pn * 256; }
        const int i4 = 4 * wc + fq;
#pragma unroll
        for (int ai = 0; ai < 2; ++ai)
#pragma unroll
            for (int m = 0; m < 4; ++m) {
                const size_t row = (size_t)(rowb + ai * HALF + m * 16);
                const float rs0 = rsv[ai * 4 + m];
                if (isgate) {
#pragma unroll
                    for (int n = 0; n < 2; ++n)
#pragma unroll
                        for (int j = 0; j < 4; ++j) { const int c = cl + 4 * n + j;
                            if (c < 36) { const float z = acc[ai][0][m][n][j] * rs0 + gbias[c]; gates[row * 36 + c] = 1.0f / (1.0f + __expf(-z)); } }
                    continue;
                }
                const float rs = rs0 * scale;
                if (rope) {
                    const int t = (int)(row & 4095);
                    const f32x4 c4 = *(const f32x4*)(cosT + t * 64 + 4 * i4), s4 = *(const f32x4*)(sinT + t * 64 + 4 * i4);
#pragma unroll
                    for (int bj = 0; bj < 2; ++bj) {
                        const f32x4 v0 = acc[ai][bj][m][0] * rs, v1 = acc[ai][bj][m][1] * rs;
                        const f32x4 lo = v0 * c4 - v1 * s4, hi = v1 * c4 + v0 * s4;
                        bf16_t* rp = dst + row * ld + colbase + bj * HALF + 4 * i4;
                        u32x2 wl, wh; wl.x = cvt_pk_bf16(lo[0], lo[1]); wl.y = cvt_pk_bf16(lo[2], lo[3]); wh.x = cvt_pk_bf16(hi[0], hi[1]); wh.y = cvt_pk_bf16(hi[2], hi[3]);
                        *(u32x2*)rp = wl; *(u32x2*)(rp + 64) = wh;
                    }
                } else {
#pragma unroll
                    for (int bj = 0; bj < 2; ++bj) {
                        const f32x4 v0 = acc[ai][bj][m][0] * rs, v1 = acc[ai][bj][m][1] * rs;
                        u32x4 w; w.x = cvt_pk_bf16(v0[0], v0[1]); w.y = cvt_pk_bf16(v0[2], v0[3]); w.z = cvt_pk_bf16(v1[0], v1[1]); w.w = cvt_pk_bf16(v1[2], v1[3]);
                        *(u32x4*)(dst + row * ld + colbase + bj * HALF + cl) = w;
                    }
                }
            }
    }
};
template <class Epi, class Sched, bool ALIGN_EPI = false, bool SP2 = false>
__device__ __forceinline__ void gemm_phase(PG8_LAS unsigned char* lds, const Gemm g, const Sched& S, const Epi& E) {
    int tid = threadIdx.x; asm volatile("" : "+v"(tid));
    const int wid = __builtin_amdgcn_readfirstlane(tid >> 6), lane = tid & 63, wr = wid >> 2, wc = wid & 3, fr = lane & 15, fq = lane >> 4;
    const int K = g.K, nt = K / BK;
    unsigned voffA[2], voffB[2];
#pragma unroll
    for (int i = 0; i < 2; ++i) { int R, C; stage_rc(tid * 16 + i * 8192, R, C); const int Rb = Epi::PERM ? ((R & ~31) + perm32(R & 31)) : R;
        voffA[i] = (unsigned)(R * K + C) * 2u; voffB[i] = (unsigned)(Rb * K + C) * 2u; }
    const size_t kstep = (size_t)(BK * 2);
    const size_t hstep = (size_t)HALF * K * 2;
    const size_t tstep = 2 * hstep;
    const unsigned ldsw = (unsigned)wid * 1024u;
    const int aoff = lds_byte(wr * 64 + fr, fq * 8), boff = lds_byte(wc * 32 + fr, fq * 8);
#define PG8_SA(b, h) (((b) * 2 + (h)) * HTB)
#define PG8_SB(b, h) ((4 + (b) * 2 + (h)) * HTB)
#define PG8_STAGE(bufoff, gbase, voff) do { _Pragma("unroll") for (int _i = 0; _i < 2; ++_i) \
        __builtin_amdgcn_global_load_lds((const unsigned*)((const char*)(gbase) + (voff)[_i]), (PG8_LAS unsigned*)(lds + (bufoff) + ldsw + _i * 8192), 16, 0, 0); } while (0)
#define PG8_LDA(dst, b, h) do { _Pragma("unroll") for (int m = 0; m < 4; ++m) _Pragma("unroll") for (int k = 0; k < 2; ++k) dst[m][k] = *(const PG8_LAS bf16x8*)(lds + PG8_SA(b, h) + aoff + m * 2048 + k * 1024); } while (0)
#define PG8_LDB(dst, b, h) do { _Pragma("unroll") for (int n = 0; n < 2; ++n) _Pragma("unroll") for (int k = 0; k < 2; ++k) dst[n][k] = *(const PG8_LAS bf16x8*)(lds + PG8_SB(b, h) + boff + n * 2048 + k * 1024); } while (0)
#define PG8_MMA(ai, bj, At, Bt) do { __builtin_amdgcn_s_setprio(1); _Pragma("unroll") for (int m = 0; m < 4; ++m) _Pragma("unroll") for (int n = 0; n < 2; ++n) _Pragma("unroll") for (int k = 0; k < 2; ++k) \
        acc[ai][bj][m][n] = __builtin_amdgcn_mfma_f32_16x16x32_bf16(Bt[n][k], At[m][k], acc[ai][bj][m][n], 0, 0, 0); __builtin_amdgcn_s_setprio(0); } while (0)
#define PG8_WAIT_V(n) asm volatile("s_waitcnt vmcnt(" #n ")" ::: "memory")
#define PG8_WAIT_L(n) asm volatile("s_waitcnt lgkmcnt(" #n ")" ::: "memory")
#define PG8_BAR __builtin_amdgcn_s_barrier()
#define PG8_SCHED __builtin_amdgcn_sched_barrier(0)
    Unit cur, nxt; int ui = 0;
    if (!S.next(0, cur)) return;
    f32x4 acc[2][2][4][2];
#pragma unroll
    for (int a = 0; a < 2; ++a)
#pragma unroll
        for (int b = 0; b < 2; ++b)
#pragma unroll
            for (int m = 0; m < 4; ++m)
#pragma unroll
                for (int n = 0; n < 2; ++n) acc[a][b][m][n] = (f32x4){0.f, 0.f, 0.f, 0.f};
    bf16x8 At[4][2], B0[2][2], B1[2][2];
    const char* cA = (const char*)g.A + (size_t)cur.pm * tstep; const char* cB = (const char*)g.Bt + (size_t)cur.pn * tstep;
    S.a_ready(cur);
    if constexpr (SP2) {
        PG8_STAGE(PG8_SB(0, 0), cB, voffB); PG8_STAGE(PG8_SB(0, 1), cB + hstep, voffB); PG8_STAGE(PG8_SA(0, 0), cA, voffA); PG8_STAGE(PG8_SA(0, 1), cA + hstep, voffA);
        if (wr == 1) PG8_BAR;
        PG8_WAIT_V(2); PG8_BAR;
        PG8_STAGE(PG8_SB(1, 0), cB + kstep, voffB); PG8_STAGE(PG8_SA(1, 0), cA + kstep, voffA); PG8_STAGE(PG8_SB(1, 1), cB + hstep + kstep, voffB);
        PG8_WAIT_V(6); PG8_BAR;
    } else {
        PG8_STAGE(PG8_SB(0, 0), cB, voffB); PG8_STAGE(PG8_SA(0, 0), cA, voffA); PG8_STAGE(PG8_SB(0, 1), cB + hstep, voffB); PG8_STAGE(PG8_SA(0, 1), cA + hstep, voffA);
        if (wr == 1) PG8_BAR;
        PG8_WAIT_V(4); PG8_BAR;
        PG8_STAGE(PG8_SB(1, 0), cB + kstep, voffB); PG8_STAGE(PG8_SA(1, 0), cA + kstep, voffA); PG8_STAGE(PG8_SB(1, 1), cB + hstep + kstep, voffB);
        PG8_WAIT_V(6); PG8_BAR;
    }
    for (;;) {
        const bool has_next = S.next(ui + 1, nxt);
        const char* nA = has_next ? (const char*)g.A + (size_t)nxt.pm * tstep : cA; const char* nB = has_next ? (const char*)g.Bt + (size_t)nxt.pn * tstep : cB;
        for (int t = 0; t < nt; t += 2) {
            const bool last = (t == nt - 2);
            const char* a1 = cA + (size_t)(t + 1) * kstep;
            const char* a2 = last ? nA : cA + (size_t)(t + 2) * kstep; const char* b2 = last ? nB : cB + (size_t)(t + 2) * kstep;
            const char* a3 = a2 + kstep; const char* b3 = b2 + kstep;
            if (last && has_next) S.a_ready(nxt);
            if constexpr (SP2) {
            PG8_LDB(B0, 0, 0); PG8_LDB(B1, 0, 1); PG8_SCHED; PG8_LDA(At, 0, 0); PG8_STAGE(PG8_SA(1, 1), a1 + hstep, voffA);
            PG8_WAIT_V(8); PG8_WAIT_L(0); PG8_BAR; PG8_MMA(0, 0, At, B0); PG8_MMA(0, 1, At, B1); PG8_BAR; PG8_SCHED;
            PG8_LDA(At, 0, 1); PG8_STAGE(PG8_SB(0, 0), b2, voffB); PG8_STAGE(PG8_SB(0, 1), b2 + hstep, voffB); PG8_STAGE(PG8_SA(0, 0), a2, voffA);
            PG8_WAIT_V(8); PG8_WAIT_L(0); PG8_BAR; PG8_MMA(1, 0, At, B0); PG8_MMA(1, 1, At, B1); PG8_BAR; PG8_SCHED;
            PG8_LDB(B0, 1, 0); PG8_LDB(B1, 1, 1); PG8_SCHED; PG8_LDA(At, 1, 0); PG8_STAGE(PG8_SA(0, 1), a2 + hstep, voffA);
            PG8_WAIT_V(8); PG8_WAIT_L(0); PG8_BAR; PG8_MMA(0, 0, At, B0); PG8_MMA(0, 1, At, B1); PG8_BAR; PG8_SCHED;
            PG8_LDA(At, 1, 1); PG8_STAGE(PG8_SB(1, 0), b3, voffB); PG8_STAGE(PG8_SB(1, 1), b3 + hstep, voffB); PG8_STAGE(PG8_SA(1, 0), a3, voffA);
            PG8_WAIT_V(8); PG8_WAIT_L(0); PG8_BAR; PG8_MMA(1, 0, At, B0); PG8_MMA(1, 1, At, B1); PG8_BAR; PG8_SCHED;
            } else {
            PG8_LDB(B0, 0, 0); PG8_SCHED; PG8_LDA(At, 0, 0); PG8_STAGE(PG8_SA(1, 1), a1 + hstep, voffA);
            PG8_WAIT_L(8); PG8_BAR; PG8_WAIT_L(0); PG8_MMA(0, 0, At, B0); PG8_BAR; PG8_SCHED;
            PG8_LDB(B1, 0, 1); PG8_STAGE(PG8_SB(0, 0), b2, voffB);
            PG8_BAR; PG8_WAIT_L(0); PG8_MMA(0, 1, At, B1); PG8_BAR;
            PG8_LDA(At, 0, 1); PG8_STAGE(PG8_SA(0, 0), a2, voffA);
            PG8_BAR; PG8_WAIT_L(0); PG8_MMA(1, 0, At, B0); PG8_BAR; PG8_SCHED;
            PG8_STAGE(PG8_SB(0, 1), b2 + hstep, voffB);
            PG8_WAIT_V(6); PG8_BAR; PG8_MMA(1, 1, At, B1); PG8_BAR;
            PG8_LDB(B0, 1, 0); PG8_SCHED; PG8_LDA(At, 1, 0); PG8_STAGE(PG8_SA(0, 1), a2 + hstep, voffA);
            PG8_WAIT_L(8); PG8_BAR; PG8_WAIT_L(0); PG8_MMA(0, 0, At, B0); PG8_BAR; PG8_SCHED;
            PG8_LDB(B1, 1, 1); PG8_STAGE(PG8_SB(1, 0), b3, voffB);
            PG8_BAR; PG8_WAIT_L(0); PG8_MMA(0, 1, At, B1); PG8_BAR;
            PG8_LDA(At, 1, 1); PG8_STAGE(PG8_SA(1, 0), a3, voffA);
            PG8_BAR; PG8_WAIT_L(0); PG8_MMA(1, 0, At, B0); PG8_BAR; PG8_SCHED;
            PG8_STAGE(PG8_SB(1, 1), b3 + hstep, voffB);
            PG8_WAIT_V(6); PG8_BAR; PG8_MMA(1, 1, At, B1); PG8_BAR;
            }
        }
        if constexpr (ALIGN_EPI) { if (wr == 0) PG8_BAR; }
        if constexpr (!Epi::AFTER_DRAIN) { E(acc, cur, wr, wc, fr, fq); S.done(cur); }
        if (!has_next) break;
#pragma unroll
        for (int a = 0; a < 2; ++a)
#pragma unroll
            for (int b = 0; b < 2; ++b)
#pragma unroll
                for (int m = 0; m < 4; ++m)
#pragma unroll
                    for (int n = 0; n < 2; ++n) acc[a][b][m][n] = (f32x4){0.f, 0.f, 0.f, 0.f};
        cur = nxt; cA = nA; cB = nB; ++ui;
        if constexpr (ALIGN_EPI) { if (wr == 1) PG8_BAR; }
    }
    PG8_WAIT_V(0);
    if constexpr (!ALIGN_EPI) { if (wr == 0) PG8_BAR; }
    PG8_BAR;
    if constexpr (Epi::AFTER_DRAIN) { E.fused(acc, cur, wr, wc, fr, fq, lds, wid, lane); S.done(cur); }
#undef PG8_SA
#undef PG8_SB
#undef PG8_STAGE
#undef PG8_LDA
#undef PG8_LDB
#undef PG8_MMA
#undef PG8_WAIT_V
#undef PG8_WAIT_L
#undef PG8_BAR
#undef PG8_SCHED
}
}

#define LAS __attribute__((address_space(3)))
typedef unsigned short bf16;
using bf16x8 = __attribute__((ext_vector_type(8))) short;
using s16x4  = __attribute__((ext_vector_type(4))) short;
using f32x16 = __attribute__((ext_vector_type(16))) float;
using f32x4  = __attribute__((ext_vector_type(4))) float;
using u32x4  = __attribute__((ext_vector_type(4))) unsigned;
using u32x2v = __attribute__((ext_vector_type(2))) unsigned;

constexpr int NB = 4, S = 4096, DM = 2048, M = NB * S, HD = 128, DFF = 5632;
constexpr int NPH = 14;
#ifndef PH_MASK
#define PH_MASK 127
#endif
constexpr int LDS_BYTES = 147456;
constexpr int NTHR = 512;

constexpr size_t MiB = 1u << 20;
constexpr size_t WS_CTL = 0, CTL_BYTES = 1 * MiB;
constexpr size_t CTL_SS1 = 131072, CTL_SS2 = 2 * 131072, CTL_SS3 = 3 * 131072, CTL_SS4 = 4 * 131072;
constexpr size_t WS_SS0 = 1 * MiB, WS_SSMEM = WS_SS0 + 65536, WS_BIAS = WS_SSMEM + 4096;
constexpr size_t WS_COS = 2 * MiB, WS_SIN = 3 * MiB;
constexpr size_t WS_WINA = 4 * MiB;
constexpr size_t WS_WOA = WS_WINA + (size_t)3840 * 2048 * 2;
constexpr size_t WS_WGUA = WS_WOA + (size_t)2048 * 2048 * 2;
constexpr size_t WS_WDA = WS_WGUA + (size_t)11264 * 2048 * 2;
constexpr size_t WS_WINB = WS_WDA + (size_t)2048 * 5632 * 2;
constexpr size_t WS_WOB = WS_WINB + (size_t)3072 * 2048 * 2;
constexpr size_t WS_WGUB = WS_WOB + (size_t)2048 * 1024 * 2;
constexpr size_t WS_WDB = WS_WGUB + (size_t)11264 * 2048 * 2;
constexpr size_t WS_WMEMA = WS_WDB + (size_t)2048 * 5632 * 2;
constexpr size_t WS_WMEMB = WS_WMEMA + (size_t)1024 * 2048 * 2;
constexpr size_t WS_W1K = WS_WMEMB + (size_t)1024 * 2048 * 2;
constexpr size_t WS_W1V = WS_W1K + (size_t)256 * 4096 * 2;
constexpr size_t WS_W2K = WS_W1V + (size_t)256 * 4096 * 2;
constexpr size_t WS_W2V = WS_W2K + (size_t)128 * 256 * 2;
constexpr size_t WS_HB = WS_W2V + (size_t)128 * 256 * 2;
constexpr size_t WS_MEMB = WS_HB + (size_t)M * DM * 2;
constexpr size_t WS_MKVA = WS_MEMB + (size_t)1024 * 2048 * 2;
constexpr size_t WS_MKVB = WS_MKVA + (size_t)1024 * 1024 * 2;
constexpr size_t WS_KC = WS_MKVB + (size_t)1024 * 1024 * 2;
constexpr size_t WS_VC = WS_KC + (size_t)NB * 256 * 2 * 128 * 2;
constexpr size_t WS_SEL = WS_VC + (size_t)NB * 256 * 2 * 128 * 2;
constexpr size_t WS_GATES = WS_SEL + (size_t)NB * 2 * S * 8;
constexpr size_t WS_OSCR = WS_GATES + (size_t)M * 36 * 4;
constexpr size_t WS_OVL = WS_OSCR + (size_t)256 * 131072;
constexpr size_t OVL_BYTES = (size_t)M * DFF * 2;
constexpr size_t WS_END = WS_OVL + OVL_BYTES;
constexpr size_t OA_Q = 0, OA_KV = (size_t)M * 1536 * 2, OA_ZM = 2 * (size_t)M * 1536 * 2, OA_O = OA_ZM + (size_t)M * 512 * 2;
constexpr size_t OB_Q = 0, OB_ZM = (size_t)M * 1536 * 2, OB_KS = OB_ZM + (size_t)M * 512 * 2, OB_VS = OB_KS + (size_t)M * 512 * 2, OB_O = OB_VS + (size_t)M * 512 * 2;
static_assert(OA_O + (size_t)M * 2048 * 2 <= OVL_BYTES && OB_O + (size_t)M * 1024 * 2 <= OVL_BYTES, "overlay");
static_assert(WS_END <= (size_t)512 * MiB, "workspace map must fit 4x the largest tensor");

struct Params { const float* in[30]; float* out; unsigned char* ws; int ph_lo, ph_hi; };

__device__ __forceinline__ float wave_sum(float v) {
#pragma unroll
    for (int o = 1; o < 64; o <<= 1) v += __shfl_xor(v, o);
    return v;
}
typedef float f32x2_t __attribute__((ext_vector_type(2))); typedef __bf16 bf16x2_t __attribute__((ext_vector_type(2)));
__device__ __forceinline__ unsigned cvtpk(float lo, float hi) { f32x2_t v = {lo, hi}; bf16x2_t b = __builtin_convertvector(v, bf16x2_t); return __builtin_bit_cast(unsigned, b); }
__device__ __forceinline__ f32x16 zero16() { f32x16 z = {}; asm volatile("" : "+v"(z)); return z; }
__device__ __forceinline__ float bf2f(unsigned short b) { return __uint_as_float(((unsigned)b) << 16); }
__device__ __forceinline__ int unperm(int p) { return 4 * (p >> 3) + (p & 3) + 64 * ((p >> 2) & 1); }

__device__ __forceinline__ int rperm(int d) { return 8 * ((d & 63) >> 2) + 4 * (d >> 6) + (d & 3); }
struct SrcMat { const float* W; const float* gain; bf16* WT; int ld, ncols, K, kind; };
__device__ __forceinline__ int dst_of(int kind, int c) {
    switch (kind) {
    case 0:
        if (c < 1536) return (c & ~127) + rperm(c & 127);
        if (c < 3072) { const int j = c - 1536, br = j >> 8; return 1536 + (j & ~127) + ((br & 1) ? (j & 127) : rperm(j & 127)); }
        if (c < 3108) return 3584 + (c - 3072);
        return 3072 + (c - 3108);
    case 1: return (c >> 7) * 256 + (c & 127);
    case 2: return (c >> 7) * 256 + 128 + (c & 127);
    case 3: return c < 1536 ? (c & ~127) + rperm(c & 127) : c;
    case 4: return c < 512 ? 2048 + (c & ~127) + rperm(c & 127) : 2048 + c;
    default: return c;
    }
}
__device__ __forceinline__ void tr_item(const SrcMat& sm, LAS float* scr, int item, int lane) {
    const int ncb = (sm.ncols + 63) >> 6, kb = item / ncb, cb = item % ncb, k0 = 64 * kb, c0 = 64 * cb;
    const int lr = lane >> 4, lc = (lane & 15) * 4;
    const bool cv = (c0 + lc) < sm.ncols;
    f32x4 v[16]; float zf = 0.f; asm volatile("" : "+v"(zf));
#pragma unroll
    for (int i = 0; i < 16; ++i) { v[i] = (f32x4){zf, zf, zf, zf}; if (cv) v[i] = *(const f32x4*)(sm.W + (size_t)(k0 + 4 * i + lr) * sm.ld + c0 + lc); }
    if (sm.gain) {
#pragma unroll
        for (int i = 0; i < 16; ++i) v[i] = v[i] * sm.gain[k0 + 4 * i + lr];
    }
#pragma unroll
    for (int i = 0; i < 16; ++i) { LAS float* s = scr + (4 * i + lr) * 65 + lc; s[0] = v[i].x; s[1] = v[i].y; s[2] = v[i].z; s[3] = v[i].w; }
    asm volatile("s_waitcnt lgkmcnt(0)" ::: "memory");
    const int c8 = lane & 7;
#pragma unroll
    for (int j = 0; j < 8; ++j) { const int n = (lane >> 3) + 8 * j; const LAS float* s = scr + (8 * c8) * 65 + n;
        u32x4 o; o.x = cvtpk(s[0 * 65], s[1 * 65]); o.y = cvtpk(s[2 * 65], s[3 * 65]); o.z = cvtpk(s[4 * 65], s[5 * 65]); o.w = cvtpk(s[6 * 65], s[7 * 65]);
        if (c0 + n < sm.ncols) *(u32x4*)(sm.WT + (size_t)dst_of(sm.kind, c0 + n) * sm.K + k0 + 8 * c8) = o; }
    asm volatile("s_waitcnt lgkmcnt(0)" ::: "memory");
}
__device__ __forceinline__ void row_to_bf16_ss(const float* xrow, bf16* orow, float* ssp, int lane) {
    const f32x4* xr = (const f32x4*)xrow + lane; float s = 0.f;
    u32x2v* o8 = (u32x2v*)orow + lane;
#pragma unroll
    for (int j = 0; j < 8; ++j) { const f32x4 v = xr[64 * j]; s += (v.x * v.x + v.y * v.y) + (v.z * v.z + v.w * v.w);
        u32x2v w; w.x = cvtpk(v.x, v.y); w.y = cvtpk(v.z, v.w); o8[64 * j] = w; }
    s = wave_sum(s);
    if (lane == 0) *ssp = s;
}
__device__ __forceinline__ void sincos_f(float a, float& sn, float& cs) {
    const float q = rintf(a * 0.636619772367581343f);
    float r = fmaf(-q, 1.5707962513e+00f, a); r = fmaf(-q, 7.5497894159e-08f, r); r = fmaf(-q, 5.3903029534e-15f, r);
    const float r2 = r * r;
    float sp = 2.7557319224e-6f; sp = fmaf(sp, r2, -1.9841269841e-4f); sp = fmaf(sp, r2, 8.3333333333e-3f); sp = fmaf(sp, r2, -1.6666666667e-1f); const float sr = fmaf(sp * r2, r, r);
    float cp = -2.7557319224e-7f; cp = fmaf(cp, r2, 2.4801587302e-5f); cp = fmaf(cp, r2, -1.3888888889e-3f); cp = fmaf(cp, r2, 4.1666666667e-2f); cp = fmaf(cp, r2, -0.5f); float one = 1.0f; asm volatile("" : "+v"(one)); const float cr = fmaf(cp, r2, one);
    const int n = ((int)q) & 3;
    sn = (n == 0) ? sr : (n == 1) ? cr : (n == 2) ? -sr : -cr;
    cs = (n == 0) ? cr : (n == 1) ? -sr : (n == 2) ? -cr : sr;
}
__device__ __forceinline__ void phase_prologue(const Params& p, unsigned char* lds_) {
    unsigned char* ws = p.ws;
    int tid = threadIdx.x; asm volatile("" : "+v"(tid));
    const int lane = tid & 63, wave = tid >> 6;
    LAS float* scr = (LAS float*)((LAS unsigned char*)lds_ + wave * 16384);
    const int gw = blockIdx.x * 8 + wave, NGW = gridDim.x * 8;
    LAS float* scr2 = (LAS float*)((LAS unsigned char*)lds_ + wave * 17408);
#define TR_SRC(src_, gain_, dstoff_, ld_, ncols_, K_, kind_) { const int ni = ((K_) / 64) * (((ncols_) + 63) / 64); if (r < ni) { \
        SrcMat sm; sm.W = (src_); sm.gain = (gain_); sm.WT = (bf16*)(ws + (dstoff_)); sm.ld = (ld_); sm.ncols = (ncols_); sm.K = (K_); sm.kind = (kind_); tr_item(sm, scr2, r, lane); continue; } r -= ni; }
    constexpr int NITEMS = 32 * 57 + 32 * 32 + 4 * 32 * 88 + 2 * 88 * 32 + 32 * 32 + 32 * 16 + 16 * 32 + 2 * 32 * 16 + 2 * 64 * 4 + 2 * 4 * 2;
    for (int it = gw; it < NITEMS; it += NGW) {
        int r = it;
        TR_SRC(p.in[15], p.in[14], WS_WGUA, DFF, DFF, 2048, 1)
        TR_SRC(p.in[16], p.in[14], WS_WGUA, DFF, DFF, 2048, 2)
        TR_SRC(p.in[26], p.in[25], WS_WGUB, DFF, DFF, 2048, 1)
        TR_SRC(p.in[27], p.in[25], WS_WGUB, DFF, DFF, 2048, 2)
        TR_SRC(p.in[17], nullptr, WS_WDA, 2048, 2048, 5632, 9)
        TR_SRC(p.in[28], nullptr, WS_WDB, 2048, 2048, 5632, 9)
        TR_SRC(p.in[3], p.in[2], WS_WINA, 3620, 3620, 2048, 0)
        TR_SRC(p.in[21], p.in[20], WS_WINB, 2048, 2048, 2048, 3)
        TR_SRC(p.in[19], p.in[18], WS_WINB, 1024, 1024, 2048, 4)
        TR_SRC(p.in[13], nullptr, WS_WOA, 2048, 2048, 2048, 9)
        TR_SRC(p.in[24], nullptr, WS_WOB, 2048, 2048, 1024, 9)
        TR_SRC(p.in[12], p.in[11], WS_WMEMA, 1024, 1024, 2048, 9)
        TR_SRC(p.in[23], p.in[22], WS_WMEMB, 1024, 1024, 2048, 9)
        TR_SRC(p.in[6], nullptr, WS_W1K, 256, 256, 4096, 9)
        TR_SRC(p.in[9], nullptr, WS_W1V, 256, 256, 4096, 9)
        TR_SRC(p.in[7], nullptr, WS_W2K, 128, 128, 256, 9)
        TR_SRC(p.in[10], nullptr, WS_W2V, 128, 128, 256, 9)
    }
#undef TR_SRC
    { u32x4* z = (u32x4*)(ws + WS_WINA + (size_t)3620 * 2048 * 2); unsigned zu = 0u; asm volatile("" : "+v"(zu)); const u32x4 zz = {zu, zu, zu, zu};
      for (int e = blockIdx.x * NTHR + tid; e < 220 * 2048 * 2 / 16; e += gridDim.x * NTHR) z[e] = zz; }
    for (int m = gw; m < M + 1024; m += NGW) {
        if (m < M) row_to_bf16_ss(p.in[0] + (size_t)m * DM, (bf16*)(ws + WS_HB) + (size_t)m * DM, (float*)(ws + WS_SS0) + m, lane);
        else { const int mm = m - M; row_to_bf16_ss(p.in[1] + (size_t)mm * DM, (bf16*)(ws + WS_MEMB) + (size_t)mm * DM, (float*)(ws + WS_SSMEM) + mm, lane); }
    }
    for (int e = blockIdx.x * NTHR + tid; e < S * 64; e += gridDim.x * NTHR) {
        const int t = e >> 6, f = e & 63;
        const float ff = (float)f, chi = 2.0762050152e-01f, clo = 4.4122106246e-09f;
        const float yh = ff * chi, ye = fmaf(ff, chi, -yh) + ff * clo;
        const float inv = __builtin_amdgcn_exp2f(-yh) * (1.0f - ye * 0.69314718056f);
        const float ang = (float)t * inv;
        float sn, cs; sincos_f(ang, sn, cs);
        ((float*)(ws + WS_COS))[e] = cs; ((float*)(ws + WS_SIN))[e] = sn;
    }
    for (int o = gw; o < 512; o += NGW) {
        const int kv = o >> 8, n = o & 255; const float* pe = p.in[kv ? 8 : 5]; const float* w1 = p.in[kv ? 9 : 6];
        float s = 0.f; for (int k = lane; k < 4096; k += 64) s += pe[k] * w1[(size_t)k * 256 + n];
        s = wave_sum(s); if (lane == 0) ((float*)(ws + WS_BIAS))[o] = s;
    }
}

constexpr int SHM_K = 16384, SHM_V = 16384;
constexpr int ATT_WS_OFF = 65536;
constexpr int ATT_UNIT_OFF = 65536 + 2048;
#define KSWZ(row, colB) ((row) * 256 + ((colB) ^ (((row) & 7) << 4)))
#define SBAR() __builtin_amdgcn_sched_barrier(0)
__device__ __forceinline__ int crow(int r, int hi) { return (r & 3) + 8 * (r >> 2) + 4 * hi; }
__device__ __forceinline__ void qkt(f32x16& p0, f32x16& p1, const char* Ks, const bf16x8 (&qr)[8], int r32, int hi) {
    p0 = zero16(); p1 = zero16();
    __builtin_amdgcn_s_setprio(1);
#pragma unroll
    for (int d0 = 0; d0 < 8; ++d0) { const int cb = (d0 * 16 + hi * 8) * 2;
        const bf16x8 b0 = *reinterpret_cast<const bf16x8*>(Ks + KSWZ(r32, cb));
        const bf16x8 b1 = *reinterpret_cast<const bf16x8*>(Ks + KSWZ(32 + r32, cb));
        p0 = __builtin_amdgcn_mfma_f32_32x32x16_bf16(b0, qr[d0], p0, 0, 0, 0);
        p1 = __builtin_amdgcn_mfma_f32_32x32x16_bf16(b1, qr[d0], p1, 0, 0, 0); }
    __builtin_amdgcn_s_setprio(0);
}
__device__ __forceinline__ void qkt_g(f32x16& p0, f32x16& p1, const char* Ks, const bf16* qp, int r32, int hi) {
    p0 = zero16(); p1 = zero16();
#pragma unroll
    for (int d0 = 0; d0 < 8; ++d0) { const int cb = (d0 * 16 + hi * 8) * 2;
        const bf16x8 q = *(const bf16x8*)(qp + d0 * 16);
        const bf16x8 b0 = *reinterpret_cast<const bf16x8*>(Ks + KSWZ(r32, cb));
        const bf16x8 b1 = *reinterpret_cast<const bf16x8*>(Ks + KSWZ(32 + r32, cb));
        p0 = __builtin_amdgcn_mfma_f32_32x32x16_bf16(b0, q, p0, 0, 0, 0);
        p1 = __builtin_amdgcn_mfma_f32_32x32x16_bf16(b1, q, p1, 0, 0, 0); }
}
__device__ __forceinline__ int v_st(int k, int c) { const int kk = (k & ~0xC) | ((k & 4) << 1) | ((k & 8) >> 1); return ((kk >> 3) * 4 + (c >> 5)) * 512 + ((kk & 7) * 32 + (c & 31)) * 2; }
__device__ __forceinline__ int v_rd_base(int lane) { return ((lane & 3) << 3) | (((lane >> 2) & 3) << 6) | (((lane >> 4) & 1) << 5) | (((lane >> 5) & 1) << 8); }
constexpr int v_rd_off(int d0, int ks, int half) { return d0 * 512 + ks * 4096 + half * 2048; }
template <int OFF> __device__ __forceinline__ s16x4 tr_read(int vb) {
    s16x4 r; asm volatile("ds_read_b64_tr_b16 %0, %1 offset:%2" : "=&v"(r) : "v"(vb), "i"(OFF) : "memory"); return r;
}
template <int D0> __device__ __forceinline__ void pv_one(f32x16& od, int vb, bf16x8 pa0, bf16x8 pa1, bf16x8 pa2, bf16x8 pa3) {
    const s16x4 l0 = tr_read<v_rd_off(D0, 0, 0)>(vb), h0 = tr_read<v_rd_off(D0, 0, 1)>(vb), l1 = tr_read<v_rd_off(D0, 1, 0)>(vb), h1 = tr_read<v_rd_off(D0, 1, 1)>(vb);
    const s16x4 l2 = tr_read<v_rd_off(D0, 2, 0)>(vb), h2 = tr_read<v_rd_off(D0, 2, 1)>(vb), l3 = tr_read<v_rd_off(D0, 3, 0)>(vb), h3 = tr_read<v_rd_off(D0, 3, 1)>(vb);
    asm volatile("s_waitcnt lgkmcnt(0)" ::: "memory"); SBAR();
#define PK(L, H) (bf16x8){L[0], L[1], L[2], L[3], H[0], H[1], H[2], H[3]}
    od = __builtin_amdgcn_mfma_f32_32x32x16_bf16(pa0, PK(l0, h0), od, 0, 0, 0);
    od = __builtin_amdgcn_mfma_f32_32x32x16_bf16(pa1, PK(l1, h1), od, 0, 0, 0);
    od = __builtin_amdgcn_mfma_f32_32x32x16_bf16(pa2, PK(l2, h2), od, 0, 0, 0);
    od = __builtin_amdgcn_mfma_f32_32x32x16_bf16(pa3, PK(l3, h3), od, 0, 0, 0);
#undef PK
}
__device__ __forceinline__ void pv_d0(f32x16 (&o)[4], int vb, bf16x8 pa0, bf16x8 pa1, bf16x8 pa2, bf16x8 pa3) {
    __builtin_amdgcn_s_setprio(1);
    pv_one<0>(o[0], vb, pa0, pa1, pa2, pa3); pv_one<1>(o[1], vb, pa0, pa1, pa2, pa3); pv_one<2>(o[2], vb, pa0, pa1, pa2, pa3); pv_one<3>(o[3], vb, pa0, pa1, pa2, pa3);
    __builtin_amdgcn_s_setprio(0);
}
__device__ __forceinline__ void p_to_frags(const f32x16& p0, const f32x16& p1, bf16x8& pa0, bf16x8& pa1, bf16x8& pa2, bf16x8& pa3) {
#define PK4(P, BASE, OUT) do { unsigned a0 = cvtpk(P[BASE + 0], P[BASE + 1]), a1 = cvtpk(P[BASE + 2], P[BASE + 3]);   \
    unsigned b0 = cvtpk(P[BASE + 4], P[BASE + 5]), b1 = cvtpk(P[BASE + 6], P[BASE + 7]);                              \
    auto r0 = __builtin_amdgcn_permlane32_swap(a0, b0, false, false); auto r1 = __builtin_amdgcn_permlane32_swap(a1, b1, false, false); \
    u32x4 w = {r0[0], r1[0], r0[1], r1[1]}; OUT = *reinterpret_cast<bf16x8*>(&w); } while (0)
    PK4(p0, 0, pa0); PK4(p0, 8, pa1); PK4(p1, 0, pa2); PK4(p1, 8, pa3);
#undef PK4
}
__device__ __forceinline__ float pair_max(float v) { auto rr = __builtin_amdgcn_permlane32_swap(__float_as_uint(v), __float_as_uint(v), false, false); return fmaxf(__uint_as_float(rr[0]), __uint_as_float(rr[1])); }
__device__ __forceinline__ float pair_sum(float v) { auto rr = __builtin_amdgcn_permlane32_swap(__float_as_uint(v), __float_as_uint(v), false, false); return __uint_as_float(rr[0]) + __uint_as_float(rr[1]); }

struct MaskNone {
    __device__ __forceinline__ bool active(int) const { return true; }
    __device__ __forceinline__ bool lane_off(int) const { return false; }
    __device__ __forceinline__ void apply(int, f32x16&, f32x16&, int) const {}
};
struct MaskBand {
    int q, W, qmin, qmax;
    __device__ __forceinline__ bool active(int kt) const { const int k0 = kt * 64; return (k0 <= qmax) && (k0 + 63 >= qmin - (W - 1)); }
    __device__ __forceinline__ bool lane_off(int) const { return false; }
    __device__ __forceinline__ void apply(int kt, f32x16& p0, f32x16& p1, int hi) const {
        const int k0 = kt * 64;
        if (k0 + 63 <= qmin && k0 >= qmax - (W - 1)) return;
#pragma unroll
        for (int r = 0; r < 16; ++r) { const int d = q - (k0 + crow(r, hi));
            p0[r] = ((unsigned)d < (unsigned)W) ? p0[r] : -INFINITY;
            p1[r] = ((unsigned)(d - 32) < (unsigned)W) ? p1[r] : -INFINITY; }
    }
};
struct MaskSel {
    int q, qmin, qmax; unsigned long long sel;
    __device__ __forceinline__ bool active(int kt) const { return (kt * 64 <= qmax) && __any((int)((sel >> kt) & 1ull)); }
    __device__ __forceinline__ bool lane_off(int kt) const { return ((sel >> kt) & 1ull) == 0ull; }
    __device__ __forceinline__ void apply(int kt, f32x16& p0, f32x16& p1, int hi) const {
        const int k0 = kt * 64;
        if (k0 + 63 <= qmin) return;
#pragma unroll
        for (int r = 0; r < 16; ++r) { const int d = q - (k0 + crow(r, hi));
            p0[r] = (d >= 0) ? p0[r] : -INFINITY;
            p1[r] = (d >= 32) ? p1[r] : -INFINITY; }
    }
};

__device__ __forceinline__ void imp_mma(f32x16& oi, bf16x8 pa, int kt, int ks, int cb, int r32, int hi) {
    int rl = r32; asm volatile("" : "+v"(rl));
    const int d0 = (64 * kt + 16 * ks + 8 * hi) - 4 * (32 * cb + rl);
    u32x4 w;
#pragma unroll
    for (int e2 = 0; e2 < 4; ++e2) {
        const int da = d0 + 2 * e2, db = da + 1;
        const unsigned lo = ((unsigned)(da + 1) <= 4u) ? 0x3F80u : 0u, hh = ((unsigned)(db + 1) <= 4u) ? 0x3F80u : 0u;
        w[e2] = lo | (hh << 16);
    }
    oi = __builtin_amdgcn_mfma_f32_32x32x16_bf16(pa, *reinterpret_cast<bf16x8*>(&w), oi, 0, 0, 0);
}

template <int MODE, bool QREG, class MaskF>
__device__ __forceinline__ void attn_stream(char* lds, const bf16x8 (&qr)[8], const bf16* qp, const bf16* Kb, const bf16* Vb, long ldk, int kt0, int kt1, const MaskF& mf,
                                            f32x16 (&o)[4], float& m_reg, float& l_reg, float inv_l, f32x16& oi0, f32x16& oi1) {
    int tid = threadIdx.x; asm volatile("" : "+v"(tid));
    const int wid = __builtin_amdgcn_readfirstlane(tid >> 6), lane = tid & 63, r32 = lane & 31, hi = lane >> 5;
    char* V_lds = lds; char* K_lds = lds + 2 * SHM_V;
    float* al_l = (float*)(lds + ATT_WS_OFF) + wid * 64;
    const int sr = tid >> 4, sc = (tid & 15) * 8, vst0 = v_st(sr, sc), vst1 = v_st(32 + sr, sc);
    const int vb0 = (int)(uintptr_t)V_lds + v_rd_base(lane);
    bf16x8 vs0 = {}, vs1 = {}, ks0, ks1;
    if (kt1 < kt0) return;
#define SLOAD(kt_) do { const long r0_ = (long)((kt_) * 64 + sr) * ldk + sc, r1_ = r0_ + 32 * ldk; ks0 = *(const bf16x8*)(Kb + r0_); ks1 = *(const bf16x8*)(Kb + r1_); \
    if (MODE == 0 || MODE == 2) { vs0 = *(const bf16x8*)(Vb + r0_); vs1 = *(const bf16x8*)(Vb + r1_); } } while (0)
#define SWRITE(b_) do { *(bf16x8*)(K_lds + (b_) * SHM_K + KSWZ(sr, sc * 2)) = ks0; *(bf16x8*)(K_lds + (b_) * SHM_K + KSWZ(32 + sr, sc * 2)) = ks1; \
    if (MODE == 0 || MODE == 2) { *(bf16x8*)(V_lds + (b_) * SHM_V + vst0) = vs0; *(bf16x8*)(V_lds + (b_) * SHM_V + vst1) = vs1; } } while (0)
    SLOAD(kt0); SWRITE(0); __syncthreads();
    for (int kt = kt0; kt <= kt1; ++kt) {
        const int buf = (kt - kt0) & 1;
        if (kt < kt1) SLOAD(kt + 1);
        if (mf.active(kt)) {
            f32x16 p0, p1;
            if (QREG) qkt(p0, p1, K_lds + buf * SHM_K, qr, r32, hi); else qkt_g(p0, p1, K_lds + buf * SHM_K, qp, r32, hi);
            mf.apply(kt, p0, p1, hi);
            if (MODE >= 2) {
                const float mfix = m_reg - __builtin_amdgcn_logf(inv_l);
#pragma unroll
                for (int r = 0; r < 16; r += 2) { const f32x2_t a = (f32x2_t){p0[r], p0[r + 1]} - mfix, bq = (f32x2_t){p1[r], p1[r + 1]} - mfix;
                    p0[r] = __builtin_amdgcn_exp2f(a.x); p0[r + 1] = __builtin_amdgcn_exp2f(a.y); p1[r] = __builtin_amdgcn_exp2f(bq.x); p1[r + 1] = __builtin_amdgcn_exp2f(bq.y); }
                bf16x8 pa0, pa1, pa2, pa3; p_to_frags(p0, p1, pa0, pa1, pa2, pa3);
                if (MODE == 2) pv_d0(o, vb0 + buf * SHM_V, pa0, pa1, pa2, pa3);
                else if (kt < 2) { imp_mma(oi0, pa0, kt, 0, 0, r32, hi); imp_mma(oi0, pa1, kt, 1, 0, r32, hi); imp_mma(oi0, pa2, kt, 2, 0, r32, hi); imp_mma(oi0, pa3, kt, 3, 0, r32, hi);
                              if (kt == 1) imp_mma(oi1, pa3, kt, 3, 1, r32, hi); }
                else { imp_mma(oi1, pa0, kt, 0, 1, r32, hi); imp_mma(oi1, pa1, kt, 1, 1, r32, hi); imp_mma(oi1, pa2, kt, 2, 1, r32, hi); imp_mma(oi1, pa3, kt, 3, 1, r32, hi); }
            } else {
                float pmax = p0[0];
#pragma unroll
                for (int r = 1; r < 16; ++r) pmax = fmaxf(pmax, p0[r]);
#pragma unroll
                for (int r = 0; r < 16; ++r) pmax = fmaxf(pmax, p1[r]);
                const bool off = mf.lane_off(kt);
                pmax = off ? -INFINITY : pmax;
                pmax = pair_max(pmax);
                float mn = m_reg, alpha = 1.f;
                if (!__all(pmax - m_reg <= 8.0f)) {
                    mn = fmaxf(m_reg, pmax); alpha = __builtin_amdgcn_exp2f(m_reg - mn); m_reg = mn; }
                const float mne = off ? INFINITY : mn;
                f32x2_t ps2 = {0.f, 0.f};
#pragma unroll
                for (int r = 0; r < 16; r += 2) { const f32x2_t a = (f32x2_t){p0[r], p0[r + 1]} - mne, bq = (f32x2_t){p1[r], p1[r + 1]} - mne;
                    p0[r] = __builtin_amdgcn_exp2f(a.x); p0[r + 1] = __builtin_amdgcn_exp2f(a.y); p1[r] = __builtin_amdgcn_exp2f(bq.x); p1[r + 1] = __builtin_amdgcn_exp2f(bq.y);
                    ps2 += (f32x2_t){p0[r], p0[r + 1]} + (f32x2_t){p1[r], p1[r + 1]}; }
                float ps = pair_sum(ps2.x + ps2.y);
                l_reg = l_reg * alpha + ps;
                if (MODE == 0) {
                    if (__any(alpha < 1.f)) {
                        if (hi == 0) al_l[r32] = alpha;
                        asm volatile("s_waitcnt lgkmcnt(0)" ::: "memory");
#pragma unroll
                        for (int r = 0; r < 16; ++r) { const float a = al_l[crow(r, hi)];
#pragma unroll
                            for (int d = 0; d < 4; ++d) o[d][r] *= a; }
                    }
                    bf16x8 pa0, pa1, pa2, pa3; p_to_frags(p0, p1, pa0, pa1, pa2, pa3);
                    pv_d0(o, vb0 + buf * SHM_V, pa0, pa1, pa2, pa3);
                }
            }
        }
        if (kt < kt1) SWRITE(buf ^ 1);
        __syncthreads();
    }
#undef SLOAD
#undef SWRITE
}
__device__ __forceinline__ void load_q(bf16x8 (&qr)[8], const bf16* qp) {
#pragma unroll
    for (int d0 = 0; d0 < 8; ++d0) qr[d0] = *(const bf16x8*)(qp + d0 * 16);
}
__device__ __forceinline__ void row_fac(float* al_l, float fac, int r32, int hi, float (&f)[16]) {
    asm volatile("s_waitcnt lgkmcnt(0)" ::: "memory");
    if (hi == 0) al_l[r32] = fac;
    asm volatile("s_waitcnt lgkmcnt(0)" ::: "memory");
#pragma unroll
    for (int r = 0; r < 16; ++r) f[r] = al_l[crow(r, hi)];
    asm volatile("s_waitcnt lgkmcnt(0)" ::: "memory");
}
template <class ValF>
__device__ __forceinline__ void store_o_tile(char* lds, int wid, int lane, const ValF& v, bf16* Ow, size_t rowstride) {
    LAS unsigned char* tb = (LAS unsigned char*)lds + wid * 8192;
    const int r32 = lane & 31, hi = lane >> 5;
#pragma unroll
    for (int r = 0; r < 16; ++r) { const int row = crow(r, hi);
#pragma unroll
        for (int d = 0; d < 4; ++d) { const int byte = (d * 32 + r32) * 2;
            *(LAS unsigned short*)(tb + row * 256 + ((((byte >> 4) ^ (row & 15)) << 4) | (byte & 15))) = (unsigned short)(cvtpk(v(d, r), 0.f) & 0xffffu); } }
    asm volatile("s_waitcnt lgkmcnt(0)" ::: "memory");
#pragma unroll
    for (int j = 0; j < 8; ++j) { const int row = (lane >> 3) + 8 * (j >> 1), ch = (lane & 7) + 8 * (j & 1);
        const u32x4 w = *(const LAS u32x4*)(tb + row * 256 + ((ch ^ (row & 15)) << 4));
        *(u32x4*)(Ow + (size_t)row * rowstride + ch * 8) = w; }
}
__device__ __forceinline__ int next_unit(char* lds, unsigned* ctr) {
    volatile int* uw = (volatile int*)(lds + ATT_UNIT_OFF);
    asm volatile("s_waitcnt lgkmcnt(0)\n\ts_barrier" ::: "memory");
    if (threadIdx.x == 0) *uw = (int)atomicAdd(ctr, 1u);
    asm volatile("s_waitcnt lgkmcnt(0)\n\ts_barrier" ::: "memory");
    return __builtin_amdgcn_readfirstlane(*uw);
}

__device__ __forceinline__ void mem_attn_unit(char* lds, int unit, const bf16* ZM, const bf16* MKV, bf16* O, int ldo, int ocol0) {
    int tid = threadIdx.x; asm volatile("" : "+v"(tid));
    const int wid = __builtin_amdgcn_readfirstlane(tid >> 6), lane = tid & 63, r32 = lane & 31, hi = lane >> 5;
    const int b = unit >> 6, h = (unit >> 4) & 3, qb = unit & 15;
    const int t = qb * 256 + wid * 32 + r32;
    bf16x8 qr[8]; load_q(qr, ZM + ((size_t)(b * S + t)) * 512 + h * 128 + hi * 8);
    f32x16 o[4] = {zero16(), zero16(), zero16(), zero16()}; float m_reg = -1e30f, l_reg = 0.f; f32x16 d0_, d1_;
    const bf16* Kb = MKV + (size_t)(b * 256) * 1024 + h * 128;
    MaskNone mk;
    attn_stream<0, true>(lds, qr, nullptr, Kb, Kb + 512, 1024, 0, 3, mk, o, m_reg, l_reg, 0.f, d0_, d1_);
    float f[16]; row_fac((float*)(lds + ATT_WS_OFF) + wid * 64, l_reg > 0.f ? 1.0f / l_reg : 0.f, r32, hi, f);
    bf16* Ow = O + ((size_t)(b * S + qb * 256 + wid * 32)) * ldo + ocol0 + h * 128;
    store_o_tile(lds, wid, lane, [&](int d, int r) { return o[d][r] * f[r]; }, Ow, (size_t)ldo);
}

__device__ __forceinline__ void nsa_cmp_unit(char* lds, int unit, unsigned char* ws, float* cmp_part) {
    int tid = threadIdx.x; asm volatile("" : "+v"(tid));
    const int wid = __builtin_amdgcn_readfirstlane(tid >> 6), lane = tid & 63, r32 = lane & 31, hi = lane >> 5;
    const int qb = 31 - (unit >> 3), b = (unit >> 1) & 3, g = unit & 1;
    const int slab = wid & 3, ht = wid >> 2;
    const int t = qb * 128 + slab * 32 + r32;
    const bf16* Q = (const bf16*)(ws + WS_OVL + OA_Q); bf16* O = (bf16*)cmp_part;
    const float* gates = (const float*)(ws + WS_GATES);
    const bf16* Kb = (const bf16*)(ws + WS_KC) + (size_t)(b * 256 * 2 + g) * 128;
    const bf16* Vb = (const bf16*)(ws + WS_VC) + (size_t)(b * 256 * 2 + g) * 128;
    float* al_l = (float*)(lds + ATT_WS_OFF) + wid * 64;
    MaskBand mk; mk.q = (t - 31) >> 4; mk.W = 1 << 30; mk.qmin = __builtin_amdgcn_readlane(mk.q, 0); mk.qmax = __builtin_amdgcn_readlane(mk.q, 31);
    LAS float* imp = (LAS float*)lds + 18432;
#pragma unroll
    for (int r = 0; r < 16; ++r) { const int q = slab * 32 + crow(r, hi); imp[(ht * 128 + q) * 64 + r32] = 0.f; imp[(ht * 128 + q) * 64 + 32 + r32] = 0.f; }
#pragma unroll 1
    for (int hh = 0; hh < 3; ++hh) {
        f32x16 oi0 = zero16(), oi1 = zero16();
        const int hq = g * 6 + ht * 3 + hh;
        const bf16* qp = Q + ((size_t)(b * S + t)) * 1536 + hq * 128 + hi * 8;
        bf16x8 qr[8] = {};
        f32x16 o[4] = {zero16(), zero16(), zero16(), zero16()}; float m_reg = -1e30f, l_reg = 0.f;
        attn_stream<1, false>(lds, qr, qp, Kb, Vb, 256, 0, 3, mk, o, m_reg, l_reg, 0.f, oi0, oi1);
        const float inv = l_reg > 0.f ? 1.0f / l_reg : 0.f;
        attn_stream<2, false>(lds, qr, qp, Kb, Vb, 256, 0, 3, mk, o, m_reg, l_reg, inv, oi0, oi1);
        attn_stream<3, false>(lds, qr, qp, Kb, Vb, 256, 0, 3, mk, o, m_reg, l_reg, inv, oi0, oi1);
#pragma unroll
        for (int r = 0; r < 16; ++r) { const int q = slab * 32 + crow(r, hi); imp[(ht * 128 + q) * 64 + r32] += oi0[r]; imp[(ht * 128 + q) * 64 + 32 + r32] += oi1[r]; }
        float f[16]; row_fac(al_l, gates[((size_t)(b * S + t)) * 36 + hq * 3 + 0], r32, hi, f);
        u32x4* Pc = (u32x4*)O + ((size_t)((((b * 2 + g) * 32 + qb) * 6 + ht * 3 + hh) * 4 + slab)) * 512 + lane;
#pragma unroll
        for (int d = 0; d < 4; ++d)
#pragma unroll
            for (int r = 0; r < 16; r += 8) { u32x4 w; w.x = cvtpk(o[d][r] * f[r], o[d][r + 1] * f[r + 1]); w.y = cvtpk(o[d][r + 2] * f[r + 2], o[d][r + 3] * f[r + 3]);
                w.z = cvtpk(o[d][r + 4] * f[r + 4], o[d][r + 5] * f[r + 5]); w.w = cvtpk(o[d][r + 6] * f[r + 6], o[d][r + 7] * f[r + 7]); Pc[(d * 2 + (r >> 3)) * 64] = w; }
    }
    __syncthreads();
    unsigned long long* SEL = (unsigned long long*)(ws + WS_SEL) + (size_t)(b * 2 + g) * S;
#pragma unroll 1
    for (int qi = 0; qi < 16; ++qi) {
        int q = wid * 16 + qi; asm volatile("" : "+v"(q));
        const int tq = qb * 128 + q, cur = tq >> 6, j = lane;
        const float v = imp[q * 64 + j] + imp[(128 + q) * 64 + j];
        const bool forced = (j == 0) || (j == cur) || (j == cur - 1), elig = (j <= cur);
        const float sc = forced ? 1e9f : (elig ? v : -1e9f);
        int cnt = 0;
#pragma unroll 4
        for (int i = 0; i < 64; ++i) { const float other = __uint_as_float(__builtin_amdgcn_readlane(__float_as_uint(sc), i));
            cnt += ((other > sc) || (other == sc && i < j)) ? 1 : 0; }
        const unsigned long long msk = __ballot((cnt < 16) && elig);
        if (lane == 0) SEL[tq] = msk;
    }
    __syncthreads();
}

__device__ __forceinline__ void nsa_main_unit(char* lds, int unit, unsigned char* ws, const float* cmp_part) {
    int tid = threadIdx.x; asm volatile("" : "+v"(tid));
    const int wid = __builtin_amdgcn_readfirstlane(tid >> 6), lane = tid & 63, r32 = lane & 31, hi = lane >> 5;
    const int qb = 31 - unit / 24, rem = unit % 24, b = rem / 6, g = (rem / 3) & 1, hp = rem % 3;
    const int slab = wid & 3, hq = g * 6 + hp * 2 + (wid >> 2);
    const int t = qb * 128 + slab * 32 + r32;
    const bf16* Q = (const bf16*)(ws + WS_OVL + OA_Q); bf16* O = (bf16*)(ws + WS_OVL + OA_O);
    const bf16* KV = (const bf16*)(ws + WS_OVL + OA_KV) + (size_t)(b * S) * 1536;
    const float* gates = (const float*)(ws + WS_GATES) + ((size_t)(b * S + t)) * 36 + hq * 3;
    float* al_l = (float*)(lds + ATT_WS_OFF) + wid * 64;
    const unsigned long long sel = ((const unsigned long long*)(ws + WS_SEL))[(size_t)(b * 2 + g) * S + t];
    bf16x8 qr[8]; load_q(qr, Q + ((size_t)(b * S + t)) * 1536 + hq * 128 + hi * 8);
    const int tmin = __builtin_amdgcn_readlane(t, 0), tmax = __builtin_amdgcn_readlane(t, 31);
    f32x16 dm0, dm1;
    {
        f32x16 o[4] = {zero16(), zero16(), zero16(), zero16()}; float m_reg = -1e30f, l_reg = 0.f;
        MaskBand mk; mk.q = t; mk.W = 512; mk.qmin = tmin; mk.qmax = tmax;
        const int lo = qb * 128 - 511, kt0 = lo <= 0 ? 0 : (lo >> 6);
        attn_stream<0, true>(lds, qr, nullptr, KV + (8 + g) * 128, KV + (10 + g) * 128, 1536, kt0, 2 * qb + 1, mk, o, m_reg, l_reg, 0.f, dm0, dm1);
        float f[16]; row_fac(al_l, l_reg > 0.f ? gates[2] / l_reg : 0.f, r32, hi, f);
        LAS u32x4* wsc = (LAS u32x4*)((LAS unsigned char*)lds + 69632 + tid * 128);
#pragma unroll
        for (int d = 0; d < 4; ++d)
#pragma unroll
            for (int r = 0; r < 16; r += 8) { u32x4 w; w.x = cvtpk(o[d][r] * f[r], o[d][r + 1] * f[r + 1]); w.y = cvtpk(o[d][r + 2] * f[r + 2], o[d][r + 3] * f[r + 3]);
                w.z = cvtpk(o[d][r + 4] * f[r + 4], o[d][r + 5] * f[r + 5]); w.w = cvtpk(o[d][r + 6] * f[r + 6], o[d][r + 7] * f[r + 7]); wsc[d * 2 + (r >> 3)] = w; }
    }
    {
        f32x16 o[4] = {zero16(), zero16(), zero16(), zero16()}; float m_reg = -1e30f, l_reg = 0.f;
        MaskSel mk; mk.q = t; mk.qmin = tmin; mk.qmax = tmax; mk.sel = sel;
        attn_stream<0, true>(lds, qr, nullptr, KV + (4 + g) * 128, KV + (6 + g) * 128, 1536, 0, 2 * qb + 1, mk, o, m_reg, l_reg, 0.f, dm0, dm1);
        float f[16]; row_fac(al_l, l_reg > 0.f ? gates[1] / l_reg : 0.f, r32, hi, f);
        bf16* Ow = O + ((size_t)(b * S + qb * 128 + slab * 32)) * 2048 + hq * 128;
        const u32x4* Pc = (const u32x4*)cmp_part + ((size_t)((((b * 2 + g) * 32 + qb) * 6 + hp * 2 + (wid >> 2)) * 4 + slab)) * 512 + lane;
        u32x4 pc[8];
#pragma unroll
        for (int j = 0; j < 8; ++j) pc[j] = Pc[j * 64];
#pragma unroll
        for (int d = 0; d < 4; ++d)
#pragma unroll
            for (int r = 0; r < 16; r += 8) { const u32x4 w = ((const LAS u32x4*)((LAS unsigned char*)lds + 69632 + tid * 128))[d * 2 + (r >> 3)];
#pragma unroll
                for (int e = 0; e < 4; ++e) { const unsigned pw = pc[d * 2 + (r >> 3)][e];
                    o[d][r + 2 * e] = o[d][r + 2 * e] * f[r + 2 * e] + __uint_as_float(w[e] << 16) + __uint_as_float(pw << 16);
                    o[d][r + 2 * e + 1] = o[d][r + 2 * e + 1] * f[r + 2 * e + 1] + __uint_as_float(w[e] & 0xffff0000u) + __uint_as_float(pw & 0xffff0000u); } }
        store_o_tile(lds, wid, lane, [&](int d, int r) { return o[d][r]; }, Ow, (size_t)2048);
    }
}

constexpr size_t OB_PO = OB_O + (size_t)M * 1024 * 2;
static_assert(OB_PO + 3 * (size_t)M * 512 * 2 <= OVL_BYTES, "dilated partials");
__device__ __forceinline__ void dil_unit(char* lds, int unit, unsigned char* ws) {
    int tid = threadIdx.x; asm volatile("" : "+v"(tid));
    const int wid = __builtin_amdgcn_readfirstlane(tid >> 6), lane = tid & 63, r32 = lane & 31, hi = lane >> 5;
    const int gi = unit >> 8, rem = unit & 255, b = rem >> 6, hg = (rem >> 4) & 3;
    const int sh = 2 * gi, nblk = 16 >> sh, blk = rem & (nblk - 1), cls = (rem & 15) >> (4 - sh);
    const int qi = 256 * blk + wid * 32 + r32, t = cls + (qi << sh);
    const bf16* Q = (const bf16*)(ws + WS_OVL + OB_Q); const bf16* KS = (const bf16*)(ws + WS_OVL + OB_KS); const bf16* VS = (const bf16*)(ws + WS_OVL + OB_VS);
    bf16* PO = (bf16*)(ws + WS_OVL + OB_PO) + (size_t)gi * M * 512;
    float* LSE = (float*)(ws + WS_OSCR) + (size_t)gi * M * 4;
    f32x16 o[4] = {zero16(), zero16(), zero16(), zero16()}; float m_reg = -1e30f, l_reg = 0.f; f32x16 dm0, dm1;
    bf16x8 qr[8]; load_q(qr, Q + ((size_t)(b * S + t)) * 1536 + (gi * 4 + hg) * 128 + hi * 8);
    MaskBand mk; mk.q = qi; mk.W = 129; mk.qmin = __builtin_amdgcn_readlane(mk.q, 0); mk.qmax = __builtin_amdgcn_readlane(mk.q, 31);
    const size_t base = ((size_t)(b * S + cls)) * 512 + hg * 128;
    const int kt0 = 4 * blk - 2 < 0 ? 0 : 4 * blk - 2;
    attn_stream<0, true>(lds, qr, nullptr, KS + base, VS + base, (long)512 << sh, kt0, 4 * blk + 3, mk, o, m_reg, l_reg, 0.f, dm0, dm1);
    if (hi == 0) LSE[((size_t)(b * S + t)) * 4 + hg] = m_reg + __builtin_amdgcn_logf(l_reg);
    float f[16]; row_fac((float*)(lds + ATT_WS_OFF) + wid * 64, l_reg > 0.f ? 1.0f / l_reg : 0.f, r32, hi, f);
    bf16* Ow = PO + ((size_t)(b * S + cls + ((256 * blk + wid * 32) << sh))) * 512 + hg * 128;
    const size_t rstride = (size_t)512 << sh;
    store_o_tile(lds, wid, lane, [&](int d, int r) { return o[d][r] * f[r]; }, Ow, rstride);
}
__device__ __forceinline__ void dil_merge(unsigned char* ws) {
    const bf16* PO = (const bf16*)(ws + WS_OVL + OB_PO); const float* LSE = (const float*)(ws + WS_OSCR);
    bf16* O = (bf16*)(ws + WS_OVL + OB_O);
    int tm = threadIdx.x; asm volatile("" : "+v"(tm));
    for (int e = blockIdx.x * NTHR + tm; e < M * 64; e += gridDim.x * NTHR) {
        const int tok = e >> 6, c8 = e & 63, hg = c8 >> 4;
        const float l0 = LSE[(size_t)tok * 4 + hg], l1 = LSE[(size_t)M * 4 + (size_t)tok * 4 + hg], l2 = LSE[(size_t)2 * M * 4 + (size_t)tok * 4 + hg];
        const float mx = fmaxf(l0, fmaxf(l1, l2));
        float w0 = __builtin_amdgcn_exp2f(l0 - mx), w1 = __builtin_amdgcn_exp2f(l1 - mx), w2 = __builtin_amdgcn_exp2f(l2 - mx);
        const float inv = 1.0f / (w0 + w1 + w2); w0 *= inv; w1 *= inv; w2 *= inv;
        const u32x4 a = *(const u32x4*)(PO + (size_t)tok * 512 + c8 * 8), bq = *(const u32x4*)(PO + (size_t)M * 512 + (size_t)tok * 512 + c8 * 8), cq = *(const u32x4*)(PO + (size_t)2 * M * 512 + (size_t)tok * 512 + c8 * 8);
        u32x4 r;
#pragma unroll
        for (int i = 0; i < 4; ++i) {
            const float lo = w0 * __uint_as_float(a[i] << 16) + w1 * __uint_as_float(bq[i] << 16) + w2 * __uint_as_float(cq[i] << 16);
            const float hh = w0 * __uint_as_float(a[i] & 0xffff0000u) + w1 * __uint_as_float(bq[i] & 0xffff0000u) + w2 * __uint_as_float(cq[i] & 0xffff0000u);
            r[i] = cvtpk(lo, hh); }
        *(u32x4*)(O + (size_t)tok * 1024 + c8 * 8) = r;
    }
}

__device__ __forceinline__ void compress_unit(char* lds, int unit, unsigned char* ws) {
    int tid = threadIdx.x; asm volatile("" : "+v"(tid));
    const int wid = __builtin_amdgcn_readfirstlane(tid >> 6), lane = tid & 63, r32 = lane & 31, hi = lane >> 5;
    const int kv = unit >> 6, g = (unit >> 5) & 1, mt = unit & 31, b = mt >> 3, c0 = (mt & 7) * 32;
    const bf16* KVp = (const bf16*)(ws + WS_OVL + OA_KV);
    const bf16* W1t = (const bf16*)(ws + (kv ? WS_W1V : WS_W1K));
    const bf16* W2t = (const bf16*)(ws + (kv ? WS_W2V : WS_W2K));
    const float* bias = (const float*)(ws + WS_BIAS) + kv * 256;
    f32x16 acc = zero16();
    const int c = c0 + r32, n = 32 * wid + r32;
    const bf16* bp = W1t + (size_t)n * 4096 + hi * 8;
    bf16x8 fa[2][8], fb[2][8];
#define CLOAD(s_, l_) do { int tok_ = 16 * c + (l_); tok_ = tok_ < S ? tok_ : S - 1; \
        const bf16* ap_ = KVp + ((size_t)(b * S + tok_)) * 1536 + (kv * 2 + g) * 128 + hi * 8; \
        _Pragma("unroll") for (int ks = 0; ks < 8; ++ks) { fa[s_][ks] = *(const bf16x8*)(ap_ + ks * 16); fb[s_][ks] = *(const bf16x8*)(bp + (l_) * 128 + ks * 16); } } while (0)
#define CMMA(s_) do { _Pragma("unroll") for (int ks = 0; ks < 8; ++ks) acc = __builtin_amdgcn_mfma_f32_32x32x16_bf16(fa[s_][ks], fb[s_][ks], acc, 0, 0, 0); } while (0)
    CLOAD(0, 0);
#pragma unroll 1
    for (int l = 0; l < 32; l += 2) {
        CLOAD(1, l + 1);
        CMMA(0);
        if (l + 2 < 32) CLOAD(0, l + 2);
        CMMA(1);
    }
#undef CLOAD
#undef CMMA
    bf16* hid = (bf16*)lds;
    const float bn = bias[n];
#pragma unroll
    for (int r = 0; r < 16; ++r) { const float z = acc[r] + bn; const float sg = z / (1.0f + __expf(-z));
        hid[crow(r, hi) * 264 + n] = (bf16)(cvtpk(sg, 0.f) & 0xffffu); }
    __syncthreads();
#ifdef CX_DUMP_HID
    { bf16* dd = (bf16*)(ws + WS_OSCR) + (size_t)unit * 8192; for (int e = tid; e < 8192; e += NTHR) dd[e] = hid[(e >> 8) * 264 + (e & 255)]; }
#endif
    if (wid < 4) {
        f32x16 a2 = zero16();
        const int n2 = 32 * wid + r32;
#pragma unroll
        for (int ks = 0; ks < 16; ++ks) {
            const bf16x8 a = *(const bf16x8*)(hid + r32 * 264 + ks * 16 + hi * 8), bb = *(const bf16x8*)(W2t + (size_t)n2 * 256 + ks * 16 + hi * 8);
            a2 = __builtin_amdgcn_mfma_f32_32x32x16_bf16(a, bb, a2, 0, 0, 0);
        }
        bf16* outp = (bf16*)(ws + (kv ? WS_VC : WS_KC));
#pragma unroll
        for (int r = 0; r < 16; ++r) { const int cc = c0 + crow(r, hi);
            outp[((size_t)(b * 256 + cc) * 2 + g) * 128 + n2] = (cc == 255) ? (bf16)0 : (bf16)(cvtpk(a2[r], 0.f) & 0xffffu); }
    }
    __syncthreads();
}

__global__ void __launch_bounds__(NTHR) fwd_kernel(Params p) {
    extern __shared__ __attribute__((aligned(16))) unsigned char lds[];
    unsigned char* ws = p.ws;
    const int tid = threadIdx.x;
    unsigned* ctl = (unsigned*)(ws + WS_CTL);
    for (int sq_ = p.ph_lo; sq_ < p.ph_hi; ++sq_) {
        const int ph = sq_ <= 9 ? sq_ : (sq_ == 10 ? 14 : sq_ - 1);
        const int rep = 0;
        const bool is_gemm = (PH_MASK & 1) && ((ph == 1) || (ph >= 5 && ph <= 8) || (ph >= 10 && ph <= 12));
        if (is_gemm) {
            const int ngem = (ph == 1) ? 3 : 1;
            for (int gi = 0; gi < ngem; ++gi) {
                pg8::Gemm g; pg8::EpiG E; int corder = (int)blockIdx.x;
                E.mode = 0; E.ss = nullptr; E.ssq = nullptr; E.res = nullptr; E.resb = nullptr; E.hout = nullptr; E.hb = nullptr; E.ssout = nullptr; E.o0 = E.o1 = E.o2 = E.o3 = nullptr;
                E.gates = nullptr; E.gbias = nullptr; E.cosT = (const float*)(ws + WS_COS); E.sinT = (const float*)(ws + WS_SIN);
                const pg8::bf16_t* HBp = (const pg8::bf16_t*)(ws + WS_HB);
                if (ph == 1 && gi == 0) {
                    g = pg8::Gemm{HBp, (const pg8::bf16_t*)(ws + WS_WINA), M, 3840, 2048};
                    E.mode = pg8::EM_INA; E.ss = (const float*)(ws + WS_SS0); E.o0 = (pg8::bf16_t*)(ws + WS_OVL + OA_Q); E.o1 = (pg8::bf16_t*)(ws + WS_OVL + OA_KV); E.o2 = (pg8::bf16_t*)(ws + WS_OVL + OA_ZM);
                    E.gates = (float*)(ws + WS_GATES); E.gbias = p.in[4];
                } else if (ph == 1) {
                    g = pg8::Gemm{(const pg8::bf16_t*)(ws + WS_MEMB), (const pg8::bf16_t*)(ws + (gi == 1 ? WS_WMEMA : WS_WMEMB)), 1024, 1024, 2048};
                    E.mode = pg8::EM_MEMKV; E.ss = (const float*)(ws + WS_SSMEM); E.o0 = (pg8::bf16_t*)(ws + (gi == 1 ? WS_MKVA : WS_MKVB));
                    corder = ((int)blockIdx.x + (int)gridDim.x - (gi == 1 ? 192 : 208)) % (int)gridDim.x;
                } else if (ph == 5) {
                    g = pg8::Gemm{(const pg8::bf16_t*)(ws + WS_OVL + OA_O), (const pg8::bf16_t*)(ws + WS_WOA), M, 2048, 2048};
                    E.mode = pg8::EM_RES; E.resb = (const pg8::bf16_t*)(ws + WS_HB); E.hout = nullptr; E.hb = (pg8::bf16_t*)(ws + WS_HB); E.ssout = (unsigned long long*)(ws + WS_CTL + CTL_SS1);
                } else if (ph == 6 || ph == 11) {
                    g = pg8::Gemm{HBp, (const pg8::bf16_t*)(ws + (ph == 6 ? WS_WGUA : WS_WGUB)), M, 11264, 2048};
                    E.mode = pg8::EM_GU; E.ssq = (const unsigned long long*)(ws + WS_CTL + (ph == 6 ? CTL_SS1 : CTL_SS3)); E.o0 = (pg8::bf16_t*)(ws + WS_OVL);
                } else if (ph == 7 || ph == 12) {
                    g = pg8::Gemm{(const pg8::bf16_t*)(ws + WS_OVL), (const pg8::bf16_t*)(ws + (ph == 7 ? WS_WDA : WS_WDB)), M, 2048, 5632};
                    E.mode = pg8::EM_RES; E.resb = (const pg8::bf16_t*)(ws + WS_HB); E.hout = nullptr; E.hb = (pg8::bf16_t*)(ws + WS_HB); E.ssout = (unsigned long long*)(ws + WS_CTL + (ph == 7 ? CTL_SS2 : CTL_SS4));
                } else if (ph == 8) {
                    g = pg8::Gemm{HBp, (const pg8::bf16_t*)(ws + WS_WINB), M, 3072, 2048};
                    E.mode = pg8::EM_INB; E.ssq = (const unsigned long long*)(ws + WS_CTL + CTL_SS2); E.o0 = (pg8::bf16_t*)(ws + WS_OVL + OB_Q); E.o2 = (pg8::bf16_t*)(ws + WS_OVL + OB_ZM);
                    E.o1 = (pg8::bf16_t*)(ws + WS_OVL + OB_KS); E.o3 = (pg8::bf16_t*)(ws + WS_OVL + OB_VS);
                } else {
                    g = pg8::Gemm{(const pg8::bf16_t*)(ws + WS_OVL + OB_O), (const pg8::bf16_t*)(ws + WS_WOB), M, 2048, 1024};
                    E.mode = pg8::EM_RES; E.resb = (const pg8::bf16_t*)(ws + WS_HB); E.hout = nullptr; E.hb = (pg8::bf16_t*)(ws + WS_HB); E.ssout = (unsigned long long*)(ws + WS_CTL + CTL_SS3);
                }
                pg8::StaticOrder So; So.init(g.M, g.N, (int)gridDim.x, corder);
                pg8::gemm_phase<pg8::EpiG, pg8::StaticOrder, true, true>((LAS unsigned char*)lds, g, So, E);
                __syncthreads();
            }
        } else if ((PH_MASK & 2) && ph == 0) {
            phase_prologue(p, lds);
        } else if ((PH_MASK & 4) && ph == 2) {
            for (int u = blockIdx.x; u < 128; u += gridDim.x) compress_unit((char*)lds, u, ws);
            for (;;) { const int u = next_unit((char*)lds, ctl + 192); if (u >= 256) break;
                mem_attn_unit((char*)lds, u, (const bf16*)(ws + WS_OVL + OA_ZM), (const bf16*)(ws + WS_MKVA), (bf16*)(ws + WS_OVL + OA_O), 2048, 1536); }
        } else if ((PH_MASK & 8) && ph == 3) {
            for (;;) { const int u = next_unit((char*)lds, ctl + 0 + rep); if (u >= 256) break; nsa_cmp_unit((char*)lds, u, ws, p.out); }
        } else if ((PH_MASK & 16) && ph == 4) {
            for (;;) { const int u = next_unit((char*)lds, ctl + 64 + rep); if (u >= 768) break; nsa_main_unit((char*)lds, u, ws, p.out); }
        } else if ((PH_MASK & 32) && ph == 9) {
            for (;;) { const int u = next_unit((char*)lds, ctl + 128 + rep); if (u >= 1024) break;
                if (u < 768) dil_unit((char*)lds, u, ws);
                else mem_attn_unit((char*)lds, u - 768, (const bf16*)(ws + WS_OVL + OB_ZM), (const bf16*)(ws + WS_MKVB), (bf16*)(ws + WS_OVL + OB_O), 1024, 512); }
        } else if (ph == 14) {
            dil_merge(ws);
        } else if ((PH_MASK & 64) && ph == 13) {
            int tl = threadIdx.x; asm volatile("" : "+v"(tl));
            const int lane = tl & 63, gw = blockIdx.x * 8 + (tl >> 6), NGW = gridDim.x * 8;
            const unsigned long long* ss4 = (const unsigned long long*)(ws + WS_CTL + CTL_SS4); const f32x4* gn = (const f32x4*)p.in[29] + lane;
            for (int m = gw; m < M; m += NGW) {
                const float rs = 1.0f / sqrtf((float)ss4[m] * 5.9604644775390625e-08f * (1.0f / 2048.0f) + 1e-6f);
                f32x4* xr = (f32x4*)(p.out + (size_t)m * DM) + lane;
                const u32x2v* hr = (const u32x2v*)((const bf16*)(ws + WS_HB) + (size_t)m * DM) + lane;
#pragma unroll
                for (int j = 0; j < 8; ++j) { const u32x2v w = hr[64 * j];
                    const f32x4 v = {__uint_as_float(w.x << 16), __uint_as_float(w.x & 0xffff0000u), __uint_as_float(w.y << 16), __uint_as_float(w.y & 0xffff0000u)};
                    xr[64 * j] = v * rs * gn[64 * j]; }
            }
        }
        if (sq_ + 1 < p.ph_hi) {
            asm volatile("s_waitcnt vmcnt(0) lgkmcnt(0)" ::: "memory");
            cg::this_grid().sync();
            __builtin_amdgcn_fence(__ATOMIC_ACQUIRE, "agent");
            asm volatile("s_waitcnt vmcnt(0)" ::: "memory");
        }
    }
}

#ifndef DBG_DUMP_N
#define DBG_DUMP_N (M * DM)
#endif
__global__ void __launch_bounds__(256) dbg_dump(const unsigned short* src, float* out, size_t n) {
    for (size_t i = (size_t)blockIdx.x * 256 + threadIdx.x; i < n; i += (size_t)gridDim.x * 256) { float v = bf2f(src[i % (size_t)(DBG_DUMP_N)]); if (!(fabsf(v) < 1e30f)) v = 12345.f; out[i] = v; }
}
extern "C" void kernel_launch(void* const* d_in, const int* in_sizes, int n_in, void* d_out, int out_size, void* d_ws, size_t ws_size, hipStream_t stream) {
    static int grid = 0;
    if (grid == 0) {
        if (n_in != 30 || in_sizes[0] != M * DM || out_size != M * DM || ws_size < WS_END) {
            fprintf(stderr, "kernel_launch: unexpected shapes: n_in %d in0 %d out %d ws %zu (need %zu)\n", n_in, n_in > 0 ? in_sizes[0] : -1, out_size, ws_size, (size_t)WS_END); grid = -1; return; }
        int dev = 0, cus = 0, per_cu = 0;
        if (hipGetDevice(&dev) != hipSuccess || hipDeviceGetAttribute(&cus, hipDeviceAttributeMultiprocessorCount, dev) != hipSuccess) { grid = -1; return; }
        if (hipFuncSetAttribute((const void*)fwd_kernel, hipFuncAttributeMaxDynamicSharedMemorySize, LDS_BYTES) != hipSuccess) { fprintf(stderr, "kernel_launch: hipFuncSetAttribute failed\n"); grid = -1; return; }
        if (hipOccupancyMaxActiveBlocksPerMultiprocessor(&per_cu, (const void*)fwd_kernel, NTHR, LDS_BYTES) != hipSuccess || per_cu < 1) { fprintf(stderr, "kernel_launch: occupancy query says %d\n", per_cu); per_cu = 1; }
        (void)hipGetLastError();
        grid = cus;
    }
    if (grid < 0) return;
    (void)hipMemsetAsync((char*)d_ws + WS_CTL, 0, CTL_BYTES, stream);
    Params prm{};
    for (int i = 0; i < 30; ++i) prm.in[i] = (const float*)d_in[i];
    prm.out = (float*)d_out; prm.ws = (unsigned char*)d_ws;
#if N_LAUNCH_MODE == 1
    prm.ph_lo = 0; prm.ph_hi = NPH + 1;
    void* args[] = {&prm};
    hipError_t e = hipLaunchCooperativeKernel((const void*)fwd_kernel, dim3(grid), dim3(NTHR), args, LDS_BYTES, stream);
    if (e != hipSuccess) fprintf(stderr, "kernel_launch: cooperative launch failed: %s (grid %d)\n", hipGetErrorString(e), grid);
#else
#ifndef DBG_STOP
#define DBG_STOP (NPH)
#endif
    for (int ph = 0; ph <= DBG_STOP; ++ph) {
        prm.ph_lo = ph; prm.ph_hi = ph + 1;
        hipLaunchKernelGGL(fwd_kernel, dim3(grid), dim3(NTHR), LDS_BYTES, stream, prm);
    }
#ifdef DBG_DUMP_OFF
    hipLaunchKernelGGL(dbg_dump, dim3(2048), dim3(256), 0, stream, (const unsigned short*)((unsigned char*)d_ws + (DBG_DUMP_OFF)), (float*)d_out, (size_t)M * DM);
#endif
    hipError_t e = hipPeekAtLastError();
    if (e != hipSuccess) fprintf(stderr, "kernel_launch: launch failed: %s\n", hipGetErrorName(e));
#endif
}
```

```cpp
#include <hip/hip_runtime.h>
#include <hip/hip_cooperative_groups.h>
#include <cstdio>
#include <cstdint>
namespace cg = cooperative_groups;
#ifndef N_LAUNCH_MODE
#define N_LAUNCH_MODE 1
#endif
namespace pg8 {
#define PG8_LAS __attribute__((address_space(3)))
typedef unsigned short bf16_t;
typedef short bf16x8 __attribute__((ext_vector_type(8)));
typedef float f32x4 __attribute__((ext_vector_type(4)));
typedef unsigned u32x4 __attribute__((ext_vector_type(4)));
constexpr int BM = 256, BK = 64, HALF = 128, HTB = HALF * BK * 2  , STAGE_BYTES = 8 * HTB, NXCD = 8, WGM = 8;

__host__ __device__ __forceinline__ int lds_byte(int r, int c) { const int st = (r >> 4) * 2 + (c >> 5), rr = r & 15, cc = c & 31, ob = rr * 64 + cc * 2; return st * 1024 + (ob ^ (((ob >> 9) & 1) << 5)); }
__host__ __device__ __forceinline__ void stage_rc(int b, int& R, int& C) { const int st = b / 1024, sb = b % 1024, swz = sb ^ (((sb >> 9) & 1) << 5); R = (st >> 1) * 16 + swz / 64; C = (st & 1) * 32 + (swz % 64) / 2; }
__host__ __device__ __forceinline__ int perm32(int rho) { const int n = rho >> 4, i = rho & 15; return 8 * (i >> 2) + 4 * n + (i & 3); }

struct Unit { int pm, pn; };
struct Gemm { const bf16_t* A; const bf16_t* Bt; int M, N, K; };

struct StaticOrder {
    int nM, nN, nwg, G, c;
    __host__ __device__ void init(int M, int N, int G_, int c_) { nM = M / BM; nN = N / BM; nwg = nM * nN; G = G_; c = c_; }
    __host__ __device__ bool next(int i, Unit& u) const {
        const long L = (long)i * G + c; if (L >= nwg) return false;
        int wgid = (int)L; { const int q = nwg / NXCD, r = nwg % NXCD, xcd = wgid % NXCD, off = wgid / NXCD; wgid = (xcd < r ? xcd * (q + 1) : r * (q + 1) + (xcd - r) * q) + off; }
        const int nig = WGM * nN, gid = wgid / nig, fm = gid * WGM, gsz = (nM - fm) < WGM ? (nM - fm) : WGM;
        u.pm = fm + ((wgid % nig) % gsz); u.pn = (wgid % nig) / gsz; return true;
    }
    __device__ __forceinline__ void a_ready(const Unit&) const {}
    __device__ __forceinline__ void done(const Unit&) const {}
};

typedef float f32x2c_t __attribute__((ext_vector_type(2))); typedef __bf16 bf16x2c_t __attribute__((ext_vector_type(2)));
__device__ __forceinline__ unsigned cvt_pk_bf16(float lo, float hi) { f32x2c_t v = {lo, hi}; bf16x2c_t b = __builtin_convertvector(v, bf16x2c_t); return __builtin_bit_cast(unsigned, b); }
typedef unsigned u32x2 __attribute__((ext_vector_type(2)));
enum { EM_INA = 0, EM_INB = 1, EM_MEMKV = 2, EM_RES = 3, EM_GU = 4 };
constexpr float QSCALE = 0.08838834764831845f * 1.4426950408889634f;
constexpr float EPSN = 1e-6f;
struct EpiG {
    static constexpr bool PERM = true, AFTER_DRAIN = false;
    int mode;
    const float* ss; const unsigned long long* ssq; const float* res; const bf16_t* resb; float* hout; bf16_t* hb; unsigned long long* ssout;
    bf16_t* o0; bf16_t* o1; bf16_t* o2; bf16_t* o3;
    float* gates; const float* gbias; const float* cosT; const float* sinT;
    __device__ __forceinline__ float rowss(size_t row) const { return ssq ? (float)ssq[row] * 5.9604644775390625e-08f : ss[row]; }
    __device__ __forceinline__ void operator()(const f32x4 (&acc)[2][2][4][2], const Unit& u, int wr, int wc, int fr, int fq) const {
        const int rowb = u.pm * BM + wr * 64 + fr;
        const int cl = wc * 32 + 8 * fq;
        if (mode == EM_RES) {
#pragma unroll
            for (int ai = 0; ai < 2; ++ai) {
                u32x4 rw[4][2];
#pragma unroll
                for (int m = 0; m < 4; ++m)
#pragma unroll
                    for (int bj = 0; bj < 2; ++bj) rw[m][bj] = *(const u32x4*)(resb + (size_t)(rowb + ai * HALF + m * 16) * 2048 + (size_t)(u.pn * BM + bj * HALF + cl));
#pragma unroll
                for (int m = 0; m < 4; ++m) {
                    const size_t row = (size_t)(rowb + ai * HALF + m * 16);
                    float sq = 0.f;
#pragma unroll
                    for (int bj = 0; bj < 2; ++bj) {
                        const size_t off = row * 2048 + (size_t)(u.pn * BM + bj * HALF + cl);
                        const u32x4 q = rw[m][bj];
                        const f32x4 r0 = (f32x4){__uint_as_float(q.x << 16), __uint_as_float(q.x & 0xffff0000u), __uint_as_float(q.y << 16), __uint_as_float(q.y & 0xffff0000u)};
                        const f32x4 r1 = (f32x4){__uint_as_float(q.z << 16), __uint_as_float(q.z & 0xffff0000u), __uint_as_float(q.w << 16), __uint_as_float(q.w & 0xffff0000u)};
                        const f32x4 h0 = r0 + acc[ai][bj][m][0], h1 = r1 + acc[ai][bj][m][1];
                        if (hout) { *(f32x4*)(hout + off) = h0; *(f32x4*)(hout + off + 4) = h1; }
                        u32x4 w; w.x = cvt_pk_bf16(h0[0], h0[1]); w.y = cvt_pk_bf16(h0[2], h0[3]); w.z = cvt_pk_bf16(h1[0], h1[1]); w.w = cvt_pk_bf16(h1[2], h1[3]);
                        if (hb) *(u32x4*)(hb + off) = w;
                        sq += (h0[0] * h0[0] + h0[1] * h0[1]) + (h0[2] * h0[2] + h0[3] * h0[3]) + (h1[0] * h1[0] + h1[1] * h1[1]) + (h1[2] * h1[2] + h1[3] * h1[3]);
                    }
                    sq += __shfl_xor(sq, 16); sq += __shfl_xor(sq, 32);
                    if (fq == 0) atomicAdd(ssout + row, (unsigned long long)(sq * 16777216.0f + 0.5f));
                }
            }
            return;
        }
        float rsv[8];
        {
            float ssv[8];
#pragma unroll
            for (int i = 0; i < 8; ++i) ssv[i] = rowss((size_t)(rowb + (i >> 2) * HALF + (i & 3) * 16));
#pragma unroll
            for (int i = 0; i < 8; ++i) rsv[i] = 1.0f / sqrtf(ssv[i] * (1.0f / 2048.0f) + EPSN);
        }
        if (mode == EM_GU) {
#pragma unroll
            for (int ai = 0; ai < 2; ++ai)
#pragma unroll
                for (int m = 0; m < 4; ++m) {
                    const size_t row = (size_t)(rowb + ai * HALF + m * 16);
                    const float rs = rsv[ai * 4 + m];
                    float a[8];
                    const float cexp = -rs * 1.4426950408889634f, rs2 = rs * rs;
#pragma unroll
                    for (int n = 0; n < 2; ++n) {
                        const f32x4 ag = acc[ai][0][m][n], au = acc[ai][1][m][n];
                        const f32x4 tt = ag * cexp;
                        f32x4 ee; ee[0] = __builtin_amdgcn_exp2f(tt[0]); ee[1] = __builtin_amdgcn_exp2f(tt[1]); ee[2] = __builtin_amdgcn_exp2f(tt[2]); ee[3] = __builtin_amdgcn_exp2f(tt[3]);
                        const f32x4 dd = ee + 1.0f;
                        f32x4 rr; rr[0] = __builtin_amdgcn_rcpf(dd[0]); rr[1] = __builtin_amdgcn_rcpf(dd[1]); rr[2] = __builtin_amdgcn_rcpf(dd[2]); rr[3] = __builtin_amdgcn_rcpf(dd[3]);
                        const f32x4 ov = ((ag * au) * rs2) * rr;
                        a[n * 4 + 0] = ov[0]; a[n * 4 + 1] = ov[1]; a[n * 4 + 2] = ov[2]; a[n * 4 + 3] = ov[3];
                    }
                    u32x4 w; w.x = cvt_pk_bf16(a[0], a[1]); w.y = cvt_pk_bf16(a[2], a[3]); w.z = cvt_pk_bf16(a[4], a[5]); w.w = cvt_pk_bf16(a[6], a[7]);
                    *(u32x4*)(o0 + row * 5632 + (size_t)(u.pn * HALF + cl)) = w;
                }
            return;
        }
        bf16_t* dst = o0; int ld = 1536, colbase = 0; bool rope = false, isgate = false; float scale = 1.f;
        const int pn = u.pn;
        if (mode == EM_INA) {
            if (pn < 6) { dst = o0; ld = 1536; colbase = pn * 256; rope = true; scale = QSCALE; }
            else if (pn < 12) { dst = o1; ld = 1536; colbase = (pn - 6) * 256; rope = (((pn - 6) & 1) == 0); }
            else if (pn < 14) { dst = o2; ld = 512; colbase = (pn - 12) * 256; scale = QSCALE; }
            else isgate = true;
        } else if (mode == EM_INB) {
            if (pn < 6) { dst = o0; ld = 1536; colbase = pn * 256; rope = true; scale = QSCALE; }
            else if (pn < 8) { dst = o2; ld = 512; colbase = (pn - 6) * 256; scale = QSCALE; }
            else if (pn < 10) { dst = o1; ld = 512; colbase = (pn - 8) * 256; rope = true; }
            else { dst = o3; ld = 512; colbase = (pn - 10) * 256; }
        } else { dst = o0; ld = 1024; colbase = pn * 256; }
        const int i4 = 4 * wc + fq;
#pragma unroll
        for (int ai = 0; ai < 2; ++ai)
#pragma unroll
            for (int m = 0; m < 4; ++m) {
                const size_t row = (size_t)(rowb + ai * HALF + m * 16);
                const float rs0 = rsv[ai * 4 + m];
                if (isgate) {
#pragma unroll
                    for (int n = 0; n < 2; ++n)
#pragma unroll
                        for (int j = 0; j < 4; ++j) { const int c = cl + 4 * n + j;
                            if (c < 36) { const float z = acc[ai][0][m][n][j] * rs0 + gbias[c]; gates[row * 36 + c] = 1.0f / (1.0f + __expf(-z)); } }
                    continue;
                }
                const float rs = rs0 * scale;
                if (rope) {
                    const int t = (int)(row & 4095);
                    const f32x4 c4 = *(const f32x4*)(cosT + t * 64 + 4 * i4), s4 = *(const f32x4*)(sinT + t * 64 + 4 * i4);
#pragma unroll
                    for (int bj = 0; bj < 2; ++bj) {
                        const f32x4 v0 = acc[ai][bj][m][0] * rs, v1 = acc[ai][bj][m][1] * rs;
                        const f32x4 lo = v0 * c4 - v1 * s4, hi = v1 * c4 + v0 * s4;
                        bf16_t* rp = dst + row * ld + colbase + bj * HALF + 4 * i4;
                        u32x2 wl, wh; wl.x = cvt_pk_bf16(lo[0], lo[1]); wl.y = cvt_pk_bf16(lo[2], lo[3]); wh.x = cvt_pk_bf16(hi[0], hi[1]); wh.y = cvt_pk_bf16(hi[2], hi[3]);
                        *(u32x2*)rp = wl; *(u32x2*)(rp + 64) = wh;
                    }
                } else {
#pragma unroll
                    for (int bj = 0; bj < 2; ++bj) {
                        const f32x4 v0 = acc[ai][bj][m][0] * rs, v1 = acc[ai][bj][m][1] * rs;
                        u32x4 w; w.x = cvt_pk_bf16(v0[0], v0[1]); w.y = cvt_pk_bf16(v0[2], v0[3]); w.z = cvt_pk_bf16(v1[0], v1[1]); w.w = cvt_pk_bf16(v1[2], v1[3]);
                        *(u32x4*)(dst + row * ld + colbase + bj * HALF + cl) = w;
                    }
                }
            }
    }
};
template <class Epi, class Sched, bool ALIGN_EPI = false, bool SP2 = false>
__device__ __forceinline__ void gemm_phase(PG8_LAS unsigned char* lds, const Gemm g, const Sched& S, const Epi& E) {
    int tid = threadIdx.x; asm volatile("" : "+v"(tid));
    const int wid = __builtin_amdgcn_readfirstlane(tid >> 6), lane = tid & 63, wr = wid >> 2, wc = wid & 3, fr = lane & 15, fq = lane >> 4;
    const int K = g.K, nt = K / BK;
    unsigned voffA[2], voffB[2];
#pragma unroll
    for (int i = 0; i < 2; ++i) { int R, C; stage_rc(tid * 16 + i * 8192, R, C); const int Rb = Epi::PERM ? ((R & ~31) + perm32(R & 31)) : R;
        voffA[i] = (unsigned)(R * K + C) * 2u; voffB[i] = (unsigned)(Rb * K + C) * 2u; }
    const size_t kstep = (size_t)(BK * 2);
    const size_t hstep = (size_t)HALF * K * 2;
    const size_t tstep = 2 * hstep;
    const unsigned ldsw = (unsigned)wid * 1024u;
    const int aoff = lds_byte(wr * 64 + fr, fq * 8), boff = lds_byte(wc * 32 + fr, fq * 8);
#define PG8_SA(b, h) (((b) * 2 + (h)) * HTB)
#define PG8_SB(b, h) ((4 + (b) * 2 + (h)) * HTB)
#define PG8_STAGE(bufoff, gbase, voff) do { _Pragma("unroll") for (int _i = 0; _i < 2; ++_i) \
        __builtin_amdgcn_global_load_lds((const unsigned*)((const char*)(gbase) + (voff)[_i]), (PG8_LAS unsigned*)(lds + (bufoff) + ldsw + _i * 8192), 16, 0, 0); } while (0)
#define PG8_LDA(dst, b, h) do { _Pragma("unroll") for (int m = 0; m < 4; ++m) _Pragma("unroll") for (int k = 0; k < 2; ++k) dst[m][k] = *(const PG8_LAS bf16x8*)(lds + PG8_SA(b, h) + aoff + m * 2048 + k * 1024); } while (0)
#define PG8_LDB(dst, b, h) do { _Pragma("unroll") for (int n = 0; n < 2; ++n) _Pragma("unroll") for (int k = 0; k < 2; ++k) dst[n][k] = *(const PG8_LAS bf16x8*)(lds + PG8_SB(b, h) + boff + n * 2048 + k * 1024); } while (0)
#define PG8_MMA(ai, bj, At, Bt) do { __builtin_amdgcn_s_setprio(1); _Pragma("unroll") for (int m = 0; m < 4; ++m) _Pragma("unroll") for (int n = 0; n < 2; ++n) _Pragma("unroll") for (int k = 0; k < 2; ++k) \
        acc[ai][bj][m][n] = __builtin_amdgcn_mfma_f32_16x16x32_bf16(Bt[n][k], At[m][k], acc[ai][bj][m][n], 0, 0, 0); __builtin_amdgcn_s_setprio(0); } while (0)
#define PG8_WAIT_V(n) asm volatile("s_waitcnt vmcnt(" #n ")" ::: "memory")
#define PG8_WAIT_L(n) asm volatile("s_waitcnt lgkmcnt(" #n ")" ::: "memory")
#define PG8_BAR __builtin_amdgcn_s_barrier()
#define PG8_SCHED __builtin_amdgcn_sched_barrier(0)
    Unit cur, nxt; int ui = 0;
    if (!S.next(0, cur)) return;
    f32x4 acc[2][2][4][2];
#pragma unroll
    for (int a = 0; a < 2; ++a)
#pragma unroll
        for (int b = 0; b < 2; ++b)
#pragma unroll
            for (int m = 0; m < 4; ++m)
#pragma unroll
                for (int n = 0; n < 2; ++n) acc[a][b][m][n] = (f32x4){0.f, 0.f, 0.f, 0.f};
    bf16x8 At[4][2], B0[2][2], B1[2][2];
    const char* cA = (const char*)g.A + (size_t)cur.pm * tstep; const char* cB = (const char*)g.Bt + (size_t)cur.pn * tstep;
    S.a_ready(cur);
    if constexpr (SP2) {
        PG8_STAGE(PG8_SB(0, 0), cB, voffB); PG8_STAGE(PG8_SB(0, 1), cB + hstep, voffB); PG8_STAGE(PG8_SA(0, 0), cA, voffA); PG8_STAGE(PG8_SA(0, 1), cA + hstep, voffA);
        if (wr == 1) PG8_BAR;
        PG8_WAIT_V(2); PG8_BAR;
        PG8_STAGE(PG8_SB(1, 0), cB + kstep, voffB); PG8_STAGE(PG8_SA(1, 0), cA + kstep, voffA); PG8_STAGE(PG8_SB(1, 1), cB + hstep + kstep, voffB);
        PG8_WAIT_V(6); PG8_BAR;
    } else {
        PG8_STAGE(PG8_SB(0, 0), cB, voffB); PG8_STAGE(PG8_SA(0, 0), cA, voffA); PG8_STAGE(PG8_SB(0, 1), cB + hstep, voffB); PG8_STAGE(PG8_SA(0, 1), cA + hstep, voffA);
        if (wr == 1) PG8_BAR;
        PG8_WAIT_V(4); PG8_BAR;
        PG8_STAGE(PG8_SB(1, 0), cB + kstep, voffB); PG8_STAGE(PG8_SA(1, 0), cA + kstep, voffA); PG8_STAGE(PG8_SB(1, 1), cB + hstep + kstep, voffB);
        PG8_WAIT_V(6); PG8_BAR;
    }
    for (;;) {
        const bool has_next = S.next(ui + 1, nxt);
        const char* nA = has_next ? (const char*)g.A + (size_t)nxt.pm * tstep : cA; const char* nB = has_next ? (const char*)g.Bt + (size_t)nxt.pn * tstep : cB;
        for (int t = 0; t < nt; t += 2) {
            const bool last = (t == nt - 2);
            const char* a1 = cA + (size_t)(t + 1) * kstep;
            const char* a2 = last ? nA : cA + (size_t)(t + 2) * kstep; const char* b2 = last ? nB : cB + (size_t)(t + 2) * kstep;
            const char* a3 = a2 + kstep; const char* b3 = b2 + kstep;
            if (last && has_next) S.a_ready(nxt);
            if constexpr (SP2) {
            PG8_LDB(B0, 0, 0); PG8_LDB(B1, 0, 1); PG8_SCHED; PG8_LDA(At, 0, 0); PG8_STAGE(PG8_SA(1, 1), a1 + hstep, voffA);
            PG8_WAIT_V(8); PG8_WAIT_L(0); PG8_BAR; PG8_MMA(0, 0, At, B0); PG8_MMA(0, 1, At, B1); PG8_BAR; PG8_SCHED;
            PG8_LDA(At, 0, 1); PG8_STAGE(PG8_SB(0, 0), b2, voffB); PG8_STAGE(PG8_SB(0, 1), b2 + hstep, voffB); PG8_STAGE(PG8_SA(0, 0), a2, voffA);
            PG8_WAIT_V(8); PG8_WAIT_L(0); PG8_BAR; PG8_MMA(1, 0, At, B0); PG8_MMA(1, 1, At, B1); PG8_BAR; PG8_SCHED;
            PG8_LDB(B0, 1, 0); PG8_LDB(B1, 1, 1); PG8_SCHED; PG8_LDA(At, 1, 0); PG8_STAGE(PG8_SA(0, 1), a2 + hstep, voffA);
            PG8_WAIT_V(8); PG8_WAIT_L(0); PG8_BAR; PG8_MMA(0, 0, At, B0); PG8_MMA(0, 1, At, B1); PG8_BAR; PG8_SCHED;
            PG8_LDA(At, 1, 1); PG8_STAGE(PG8_SB(1, 0), b3, voffB); PG8_STAGE(PG8_SB(1, 1), b3 + hstep, voffB); PG8_STAGE(PG8_SA(1, 0), a3, voffA);
            PG8_WAIT_V(8); PG8_WAIT_L(0); PG8_BAR; PG8_MMA(1, 0, At, B0); PG8_MMA(1, 1, At, B1); PG8_BAR; PG8_SCHED;
            } else {
            PG8_LDB(B0, 0, 0); PG8_SCHED; PG8_LDA(At, 0, 0); PG8_STAGE(PG8_SA(1, 1), a1 + hstep, voffA);
            PG8_WAIT_L(8); PG8_BAR; PG8_WAIT_L(0); PG8_MMA(0, 0, At, B0); PG8_BAR; PG8_SCHED;
            PG8_LDB(B1, 0, 1); PG8_STAGE(PG8_SB(0, 0), b2, voffB);
            PG8_BAR; PG8_WAIT_L(0); PG8_MMA(0, 1, At, B1); PG8_BAR;
            PG8_LDA(At, 0, 1); PG8_STAGE(PG8_SA(0, 0), a2, voffA);
            PG8_BAR; PG8_WAIT_L(0); PG8_MMA(1, 0, At, B0); PG8_BAR; PG8_SCHED;
            PG8_STAGE(PG8_SB(0, 1), b2 + hstep, voffB);
            PG8_WAIT_V(6); PG8_BAR; PG8_MMA(1, 1, At, B1); PG8_BAR;
            PG8_LDB(B0, 1, 0); PG8_SCHED; PG8_LDA(At, 1, 0); PG8_STAGE(PG8_SA(0, 1), a2 + hstep, voffA);
            PG8_WAIT_L(8); PG8_BAR; PG8_WAIT_L(0); PG8_MMA(0, 0, At, B0); PG8_BAR; PG8_SCHED;
            PG8_LDB(B1, 1, 1); PG8_STAGE(PG8_SB(1, 0), b3, voffB);
            PG8_BAR; PG8_WAIT_L(0); PG8_MMA(0, 1, At, B1); PG8_BAR;
            PG8_LDA(At, 1, 1); PG8_STAGE(PG8_SA(1, 0), a3, voffA);
            PG8_BAR; PG8_WAIT_L(0); PG8_MMA(1, 0, At, B0); PG8_BAR; PG8_SCHED;
            PG8_STAGE(PG8_SB(1, 1), b3 + hstep, voffB);
            PG8_WAIT_V(6); PG8_BAR; PG8_MMA(1, 1, At, B1); PG8_BAR;
            }
        }
        if constexpr (ALIGN_EPI) { if (wr == 0) PG8_BAR; }
        if constexpr (!Epi::AFTER_DRAIN) { E(acc, cur, wr, wc, fr, fq); S.done(cur); }
        if (!has_next) break;
#pragma unroll
        for (int a = 0; a < 2; ++a)
#pragma unroll
            for (int b = 0; b < 2; ++b)
#pragma unroll
                for (int m = 0; m < 4; ++m)
#pragma unroll
                    for (int n = 0; n < 2; ++n) acc[a][b][m][n] = (f32x4){0.f, 0.f, 0.f, 0.f};
        cur = nxt; cA = nA; cB = nB; ++ui;
        if constexpr (ALIGN_EPI) { if (wr == 1) PG8_BAR; }
    }
    PG8_WAIT_V(0);
    if constexpr (!ALIGN_EPI) { if (wr == 0) PG8_BAR; }
    PG8_BAR;
    if constexpr (Epi::AFTER_DRAIN) { E.fused(acc, cur, wr, wc, fr, fq, lds, wid, lane); S.done(cur); }
#undef PG8_SA
#undef PG8_SB
#undef PG8_STAGE
#undef PG8_LDA
#undef PG8_LDB
#undef PG8_MMA
#undef PG8_WAIT_V
#undef PG8_WAIT_L
#undef PG8_BAR
#undef PG8_SCHED
}
}

#define LAS __attribute__((address_space(3)))
typedef unsigned short bf16;
using bf16x8 = __attribute__((ext_vector_type(8))) short;
using s16x4  = __attribute__((ext_vector_type(4))) short;
using f32x16 = __attribute__((ext_vector_type(16))) float;
using f32x4  = __attribute__((ext_vector_type(4))) float;
using u32x4  = __attribute__((ext_vector_type(4))) unsigned;
using u32x2v = __attribute__((ext_vector_type(2))) unsigned;

constexpr int NB = 4, S = 4096, DM = 2048, M = NB * S, HD = 128, DFF = 5632;
constexpr int NPH = 14;
#ifndef PH_MASK
#define PH_MASK 127
#endif
constexpr int LDS_BYTES = 147456;
constexpr int NTHR = 512;

constexpr size_t MiB = 1u << 20;
constexpr size_t WS_CTL = 0, CTL_BYTES = 1 * MiB;
constexpr size_t CTL_SS1 = 131072, CTL_SS2 = 2 * 131072, CTL_SS3 = 3 * 131072, CTL_SS4 = 4 * 131072;
constexpr size_t WS_SS0 = 1 * MiB, WS_SSMEM = WS_SS0 + 65536, WS_BIAS = WS_SSMEM + 4096;
constexpr size_t WS_COS = 2 * MiB, WS_SIN = 3 * MiB;
constexpr size_t WS_WINA = 4 * MiB;
constexpr size_t WS_WOA = WS_WINA + (size_t)3840 * 2048 * 2;
constexpr size_t WS_WGUA = WS_WOA + (size_t)2048 * 2048 * 2;
constexpr size_t WS_WDA = WS_WGUA + (size_t)11264 * 2048 * 2;
constexpr size_t WS_WINB = WS_WDA + (size_t)2048 * 5632 * 2;
constexpr size_t WS_WOB = WS_WINB + (size_t)3072 * 2048 * 2;
constexpr size_t WS_WGUB = WS_WOB + (size_t)2048 * 1024 * 2;
constexpr size_t WS_WDB = WS_WGUB + (size_t)11264 * 2048 * 2;
constexpr size_t WS_WMEMA = WS_WDB + (size_t)2048 * 5632 * 2;
constexpr size_t WS_WMEMB = WS_WMEMA + (size_t)1024 * 2048 * 2;
constexpr size_t WS_W1K = WS_WMEMB + (size_t)1024 * 2048 * 2;
constexpr size_t WS_W1V = WS_W1K + (size_t)256 * 4096 * 2;
constexpr size_t WS_W2K = WS_W1V + (size_t)256 * 4096 * 2;
constexpr size_t WS_W2V = WS_W2K + (size_t)128 * 256 * 2;
constexpr size_t WS_HB = WS_W2V + (size_t)128 * 256 * 2;
constexpr size_t WS_MEMB = WS_HB + (size_t)M * DM * 2;
constexpr size_t WS_MKVA = WS_MEMB + (size_t)1024 * 2048 * 2;
constexpr size_t WS_MKVB = WS_MKVA + (size_t)1024 * 1024 * 2;
constexpr size_t WS_KC = WS_MKVB + (size_t)1024 * 1024 * 2;
constexpr size_t WS_VC = WS_KC + (size_t)NB * 256 * 2 * 128 * 2;
constexpr size_t WS_SEL = WS_VC + (size_t)NB * 256 * 2 * 128 * 2;
constexpr size_t WS_GATES = WS_SEL + (size_t)NB * 2 * S * 8;
constexpr size_t WS_OSCR = WS_GATES + (size_t)M * 36 * 4;
constexpr size_t WS_OVL = WS_OSCR + (size_t)256 * 131072;
constexpr size_t OVL_BYTES = (size_t)M * DFF * 2;
constexpr size_t WS_END = WS_OVL + OVL_BYTES;
constexpr size_t OA_Q = 0, OA_KV = (size_t)M * 1536 * 2, OA_ZM = 2 * (size_t)M * 1536 * 2, OA_O = OA_ZM + (size_t)M * 512 * 2;
constexpr size_t OB_Q = 0, OB_ZM = (size_t)M * 1536 * 2, OB_KS = OB_ZM + (size_t)M * 512 * 2, OB_VS = OB_KS + (size_t)M * 512 * 2, OB_O = OB_VS + (size_t)M * 512 * 2;
static_assert(OA_O + (size_t)M * 2048 * 2 <= OVL_BYTES && OB_O + (size_t)M * 1024 * 2 <= OVL_BYTES, "overlay");
static_assert(WS_END <= (size_t)512 * MiB, "workspace map must fit 4x the largest tensor");

struct Params { const float* in[30]; float* out; unsigned char* ws; int ph_lo, ph_hi; };

__device__ __forceinline__ float wave_sum(float v) {
#pragma unroll
    for (int o = 1; o < 64; o <<= 1) v += __shfl_xor(v, o);
    return v;
}
typedef float f32x2_t __attribute__((ext_vector_type(2))); typedef __bf16 bf16x2_t __attribute__((ext_vector_type(2)));
__device__ __forceinline__ unsigned cvtpk(float lo, float hi) { f32x2_t v = {lo, hi}; bf16x2_t b = __builtin_convertvector(v, bf16x2_t); return __builtin_bit_cast(unsigned, b); }
__device__ __forceinline__ f32x16 zero16() { f32x16 z = {}; asm volatile("" : "+v"(z)); return z; }
__device__ __forceinline__ float bf2f(unsigned short b) { return __uint_as_float(((unsigned)b) << 16); }
__device__ __forceinline__ int unperm(int p) { return 4 * (p >> 3) + (p & 3) + 64 * ((p >> 2) & 1); }

__device__ __forceinline__ int rperm(int d) { return 8 * ((d & 63) >> 2) + 4 * (d >> 6) + (d & 3); }
struct SrcMat { const float* W; const float* gain; bf16* WT; int ld, ncols, K, kind; };
__device__ __forceinline__ int dst_of(int kind, int c) {
    switch (kind) {
    case 0:
        if (c < 1536) return (c & ~127) + rperm(c & 127);
        if (c < 3072) { const int j = c - 1536, br = j >> 8; return 1536 + (j & ~127) + ((br & 1) ? (j & 127) : rperm(j & 127)); }
        if (c < 3108) return 3584 + (c - 3072);
        return 3072 + (c - 3108);
    case 1: return (c >> 7) * 256 + (c & 127);
    case 2: return (c >> 7) * 256 + 128 + (c & 127);
    case 3: return c < 1536 ? (c & ~127) + rperm(c & 127) : c;
    case 4: return c < 512 ? 2048 + (c & ~127) + rperm(c & 127) : 2048 + c;
    default: return c;
    }
}
__device__ __forceinline__ void tr_item(const SrcMat& sm, LAS float* scr, int item, int lane) {
    const int ncb = (sm.ncols + 63) >> 6, kb = item / ncb, cb = item % ncb, k0 = 64 * kb, c0 = 64 * cb;
    const int lr = lane >> 4, lc = (lane & 15) * 4;
    const bool cv = (c0 + lc) < sm.ncols;
    f32x4 v[16]; float zf = 0.f; asm volatile("" : "+v"(zf));
#pragma unroll
    for (int i = 0; i < 16; ++i) { v[i] = (f32x4){zf, zf, zf, zf}; if (cv) v[i] = *(const f32x4*)(sm.W + (size_t)(k0 + 4 * i + lr) * sm.ld + c0 + lc); }
    if (sm.gain) {
#pragma unroll
        for (int i = 0; i < 16; ++i) v[i] = v[i] * sm.gain[k0 + 4 * i + lr];
    }
#pragma unroll
    for (int i = 0; i < 16; ++i) { LAS float* s = scr + (4 * i + lr) * 65 + lc; s[0] = v[i].x; s[1] = v[i].y; s[2] = v[i].z; s[3] = v[i].w; }
    asm volatile("s_waitcnt lgkmcnt(0)" ::: "memory");
    const int c8 = lane & 7;
#pragma unroll
    for (int j = 0; j < 8; ++j) { const int n = (lane >> 3) + 8 * j; const LAS float* s = scr + (8 * c8) * 65 + n;
        u32x4 o; o.x = cvtpk(s[0 * 65], s[1 * 65]); o.y = cvtpk(s[2 * 65], s[3 * 65]); o.z = cvtpk(s[4 * 65], s[5 * 65]); o.w = cvtpk(s[6 * 65], s[7 * 65]);
        if (c0 + n < sm.ncols) *(u32x4*)(sm.WT + (size_t)dst_of(sm.kind, c0 + n) * sm.K + k0 + 8 * c8) = o; }
    asm volatile("s_waitcnt lgkmcnt(0)" ::: "memory");
}
__device__ __forceinline__ void row_to_bf16_ss(const float* xrow, bf16* orow, float* ssp, int lane) {
    const f32x4* xr = (const f32x4*)xrow + lane; float s = 0.f;
    u32x2v* o8 = (u32x2v*)orow + lane;
#pragma unroll
    for (int j = 0; j < 8; ++j) { const f32x4 v = xr[64 * j]; s += (v.x * v.x + v.y * v.y) + (v.z * v.z + v.w * v.w);
        u32x2v w; w.x = cvtpk(v.x, v.y); w.y = cvtpk(v.z, v.w); o8[64 * j] = w; }
    s = wave_sum(s);
    if (lane == 0) *ssp = s;
}
__device__ __forceinline__ void sincos_f(float a, float& sn, float& cs) {
    const float q = rintf(a * 0.636619772367581343f);
    float r = fmaf(-q, 1.5707962513e+00f, a); r = fmaf(-q, 7.5497894159e-08f, r); r = fmaf(-q, 5.3903029534e-15f, r);
    const float r2 = r * r;
    float sp = 2.7557319224e-6f; sp = fmaf(sp, r2, -1.9841269841e-4f); sp = fmaf(sp, r2, 8.3333333333e-3f); sp = fmaf(sp, r2, -1.6666666667e-1f); const float sr = fmaf(sp * r2, r, r);
    float cp = -2.7557319224e-7f; cp = fmaf(cp, r2, 2.4801587302e-5f); cp = fmaf(cp, r2, -1.3888888889e-3f); cp = fmaf(cp, r2, 4.1666666667e-2f); cp = fmaf(cp, r2, -0.5f); float one = 1.0f; asm volatile("" : "+v"(one)); const float cr = fmaf(cp, r2, one);
    const int n = ((int)q) & 3;
    sn = (n == 0) ? sr : (n == 1) ? cr : (n == 2) ? -sr : -cr;
    cs = (n == 0) ? cr : (n == 1) ? -sr : (n == 2) ? -cr : sr;
}
__device__ __forceinline__ void phase_prologue(const Params& p, unsigned char* lds_) {
    unsigned char* ws = p.ws;
    int tid = threadIdx.x; asm volatile("" : "+v"(tid));
    const int lane = tid & 63, wave = tid >> 6;
    LAS float* scr = (LAS float*)((LAS unsigned char*)lds_ + wave * 16384);
    const int gw = blockIdx.x * 8 + wave, NGW = gridDim.x * 8;
    LAS float* scr2 = (LAS float*)((LAS unsigned char*)lds_ + wave * 17408);
#define TR_SRC(src_, gain_, dstoff_, ld_, ncols_, K_, kind_) { const int ni = ((K_) / 64) * (((ncols_) + 63) / 64); if (r < ni) { \
        SrcMat sm; sm.W = (src_); sm.gain = (gain_); sm.WT = (bf16*)(ws + (dstoff_)); sm.ld = (ld_); sm.ncols = (ncols_); sm.K = (K_); sm.kind = (kind_); tr_item(sm, scr2, r, lane); continue; } r -= ni; }
    constexpr int NITEMS = 32 * 57 + 32 * 32 + 4 * 32 * 88 + 2 * 88 * 32 + 32 * 32 + 32 * 16 + 16 * 32 + 2 * 32 * 16 + 2 * 64 * 4 + 2 * 4 * 2;
    for (int it = gw; it < NITEMS; it += NGW) {
        int r = it;
        TR_SRC(p.in[15], p.in[14], WS_WGUA, DFF, DFF, 2048, 1)
        TR_SRC(p.in[16], p.in[14], WS_WGUA, DFF, DFF, 2048, 2)
        TR_SRC(p.in[26], p.in[25], WS_WGUB, DFF, DFF, 2048, 1)
        TR_SRC(p.in[27], p.in[25], WS_WGUB, DFF, DFF, 2048, 2)
        TR_SRC(p.in[17], nullptr, WS_WDA, 2048, 2048, 5632, 9)
        TR_SRC(p.in[28], nullptr, WS_WDB, 2048, 2048, 5632, 9)
        TR_SRC(p.in[3], p.in[2], WS_WINA, 3620, 3620, 2048, 0)
        TR_SRC(p.in[21], p.in[20], WS_WINB, 2048, 2048, 2048, 3)
        TR_SRC(p.in[19], p.in[18], WS_WINB, 1024, 1024, 2048, 4)
        TR_SRC(p.in[13], nullptr, WS_WOA, 2048, 2048, 2048, 9)
        TR_SRC(p.in[24], nullptr, WS_WOB, 2048, 2048, 1024, 9)
        TR_SRC(p.in[12], p.in[11], WS_WMEMA, 1024, 1024, 2048, 9)
        TR_SRC(p.in[23], p.in[22], WS_WMEMB, 1024, 1024, 2048, 9)
        TR_SRC(p.in[6], nullptr, WS_W1K, 256, 256, 4096, 9)
        TR_SRC(p.in[9], nullptr, WS_W1V, 256, 256, 4096, 9)
        TR_SRC(p.in[7], nullptr, WS_W2K, 128, 128, 256, 9)
        TR_SRC(p.in[10], nullptr, WS_W2V, 128, 128, 256, 9)
    }
#undef TR_SRC
    { u32x4* z = (u32x4*)(ws + WS_WINA + (size_t)3620 * 2048 * 2); unsigned zu = 0u; asm volatile("" : "+v"(zu)); const u32x4 zz = {zu, zu, zu, zu};
      for (int e = blockIdx.x * NTHR + tid; e < 220 * 2048 * 2 / 16; e += gridDim.x * NTHR) z[e] = zz; }
    for (int m = gw; m < M + 1024; m += NGW) {
        if (m < M) row_to_bf16_ss(p.in[0] + (size_t)m * DM, (bf16*)(ws + WS_HB) + (size_t)m * DM, (float*)(ws + WS_SS0) + m, lane);
        else { const int mm = m - M; row_to_bf16_ss(p.in[1] + (size_t)mm * DM, (bf16*)(ws + WS_MEMB) + (size_t)mm * DM, (float*)(ws + WS_SSMEM) + mm, lane); }
    }
    for (int e = blockIdx.x * NTHR + tid; e < S * 64; e += gridDim.x * NTHR) {
        const int t = e >> 6, f = e & 63;
        const float ff = (float)f, chi = 2.0762050152e-01f, clo = 4.4122106246e-09f;
        const float yh = ff * chi, ye = fmaf(ff, chi, -yh) + ff * clo;
        const float inv = __builtin_amdgcn_exp2f(-yh) * (1.0f - ye * 0.69314718056f);
        const float ang = (float)t * inv;
        float sn, cs; sincos_f(ang, sn, cs);
        ((float*)(ws + WS_COS))[e] = cs; ((float*)(ws + WS_SIN))[e] = sn;
    }
    for (int o = gw; o < 512; o += NGW) {
        const int kv = o >> 8, n = o & 255; const float* pe = p.in[kv ? 8 : 5]; const float* w1 = p.in[kv ? 9 : 6];
        float s = 0.f; for (int k = lane; k < 4096; k += 64) s += pe[k] * w1[(size_t)k * 256 + n];
        s = wave_sum(s); if (lane == 0) ((float*)(ws + WS_BIAS))[o] = s;
    }
}

constexpr int SHM_K = 16384, SHM_V = 16384;
constexpr int ATT_WS_OFF = 65536;
constexpr int ATT_UNIT_OFF = 65536 + 2048;
#define KSWZ(row, colB) ((row) * 256 + ((colB) ^ (((row) & 7) << 4)))
#define SBAR() __builtin_amdgcn_sched_barrier(0)
__device__ __forceinline__ int crow(int r, int hi) { return (r & 3) + 8 * (r >> 2) + 4 * hi; }
__device__ __forceinline__ void qkt(f32x16& p0, f32x16& p1, const char* Ks, const bf16x8 (&qr)[8], int r32, int hi) {
    p0 = zero16(); p1 = zero16();
    __builtin_amdgcn_s_setprio(1);
#pragma unroll
    for (int d0 = 0; d0 < 8; ++d0) { const int cb = (d0 * 16 + hi * 8) * 2;
        const bf16x8 b0 = *reinterpret_cast<const bf16x8*>(Ks + KSWZ(r32, cb));
        const bf16x8 b1 = *reinterpret_cast<const bf16x8*>(Ks + KSWZ(32 + r32, cb));
        p0 = __builtin_amdgcn_mfma_f32_32x32x16_bf16(b0, qr[d0], p0, 0, 0, 0);
        p1 = __builtin_amdgcn_mfma_f32_32x32x16_bf16(b1, qr[d0], p1, 0, 0, 0); }
    __builtin_amdgcn_s_setprio(0);
}
__device__ __forceinline__ void qkt_g(f32x16& p0, f32x16& p1, const char* Ks, const bf16* qp, int r32, int hi) {
    p0 = zero16(); p1 = zero16();
#pragma unroll
    for (int d0 = 0; d0 < 8; ++d0) { const int cb = (d0 * 16 + hi * 8) * 2;
        const bf16x8 q = *(const bf16x8*)(qp + d0 * 16);
        const bf16x8 b0 = *reinterpret_cast<const bf16x8*>(Ks + KSWZ(r32, cb));
        const bf16x8 b1 = *reinterpret_cast<const bf16x8*>(Ks + KSWZ(32 + r32, cb));
        p0 = __builtin_amdgcn_mfma_f32_32x32x16_bf16(b0, q, p0, 0, 0, 0);
        p1 = __builtin_amdgcn_mfma_f32_32x32x16_bf16(b1, q, p1, 0, 0, 0); }
}
__device__ __forceinline__ int v_st(int k, int c) { const int kk = (k & ~0xC) | ((k & 4) << 1) | ((k & 8) >> 1); return ((kk >> 3) * 4 + (c >> 5)) * 512 + ((kk & 7) * 32 + (c & 31)) * 2; }
__device__ __forceinline__ int v_rd_base(int lane) { return ((lane & 3) << 3) | (((lane >> 2) & 3) << 6) | (((lane >> 4) & 1) << 5) | (((lane >> 5) & 1) << 8); }
constexpr int v_rd_off(int d0, int ks, int half) { return d0 * 512 + ks * 4096 + half * 2048; }
template <int OFF> __device__ __forceinline__ s16x4 tr_read(int vb) {
    s16x4 r; asm volatile("ds_read_b64_tr_b16 %0, %1 offset:%2" : "=&v"(r) : "v"(vb), "i"(OFF) : "memory"); return r;
}
template <int D0> __device__ __forceinline__ void pv_one(f32x16& od, int vb, bf16x8 pa0, bf16x8 pa1, bf16x8 pa2, bf16x8 pa3) {
    const s16x4 l0 = tr_read<v_rd_off(D0, 0, 0)>(vb), h0 = tr_read<v_rd_off(D0, 0, 1)>(vb), l1 = tr_read<v_rd_off(D0, 1, 0)>(vb), h1 = tr_read<v_rd_off(D0, 1, 1)>(vb);
    const s16x4 l2 = tr_read<v_rd_off(D0, 2, 0)>(vb), h2 = tr_read<v_rd_off(D0, 2, 1)>(vb), l3 = tr_read<v_rd_off(D0, 3, 0)>(vb), h3 = tr_read<v_rd_off(D0, 3, 1)>(vb);
    asm volatile("s_waitcnt lgkmcnt(0)" ::: "memory"); SBAR();
#define PK(L, H) (bf16x8){L[0], L[1], L[2], L[3], H[0], H[1], H[2], H[3]}
    od = __builtin_amdgcn_mfma_f32_32x32x16_bf16(pa0, PK(l0, h0), od, 0, 0, 0);
    od = __builtin_amdgcn_mfma_f32_32x32x16_bf16(pa1, PK(l1, h1), od, 0, 0, 0);
    od = __builtin_amdgcn_mfma_f32_32x32x16_bf16(pa2, PK(l2, h2), od, 0, 0, 0);
    od = __builtin_amdgcn_mfma_f32_32x32x16_bf16(pa3, PK(l3, h3), od, 0, 0, 0);
#undef PK
}
__device__ __forceinline__ void pv_d0(f32x16 (&o)[4], int vb, bf16x8 pa0, bf16x8 pa1, bf16x8 pa2, bf16x8 pa3) {
    __builtin_amdgcn_s_setprio(1);
    pv_one<0>(o[0], vb, pa0, pa1, pa2, pa3); pv_one<1>(o[1], vb, pa0, pa1, pa2, pa3); pv_one<2>(o[2], vb, pa0, pa1, pa2, pa3); pv_one<3>(o[3], vb, pa0, pa1, pa2, pa3);
    __builtin_amdgcn_s_setprio(0);
}
__device__ __forceinline__ void p_to_frags(const f32x16& p0, const f32x16& p1, bf16x8& pa0, bf16x8& pa1, bf16x8& pa2, bf16x8& pa3) {
#define PK4(P, BASE, OUT) do { unsigned a0 = cvtpk(P[BASE + 0], P[BASE + 1]), a1 = cvtpk(P[BASE + 2], P[BASE + 3]);   \
    unsigned b0 = cvtpk(P[BASE + 4], P[BASE + 5]), b1 = cvtpk(P[BASE + 6], P[BASE + 7]);                              \
    auto r0 = __builtin_amdgcn_permlane32_swap(a0, b0, false, false); auto r1 = __builtin_amdgcn_permlane32_swap(a1, b1, false, false); \
    u32x4 w = {r0[0], r1[0], r0[1], r1[1]}; OUT = *reinterpret_cast<bf16x8*>(&w); } while (0)
    PK4(p0, 0, pa0); PK4(p0, 8, pa1); PK4(p1, 0, pa2); PK4(p1, 8, pa3);
#undef PK4
}
__device__ __forceinline__ float pair_max(float v) { auto rr = __builtin_amdgcn_permlane32_swap(__float_as_uint(v), __float_as_uint(v), false, false); return fmaxf(__uint_as_float(rr[0]), __uint_as_float(rr[1])); }
__device__ __forceinline__ float pair_sum(float v) { auto rr = __builtin_amdgcn_permlane32_swap(__float_as_uint(v), __float_as_uint(v), false, false); return __uint_as_float(rr[0]) + __uint_as_float(rr[1]); }

struct MaskNone {
    __device__ __forceinline__ bool active(int) const { return true; }
    __device__ __forceinline__ bool lane_off(int) const { return false; }
    __device__ __forceinline__ void apply(int, f32x16&, f32x16&, int) const {}
};
struct MaskBand {
    int q, W, qmin, qmax;
    __device__ __forceinline__ bool active(int kt) const { const int k0 = kt * 64; return (k0 <= qmax) && (k0 + 63 >= qmin - (W - 1)); }
    __device__ __forceinline__ bool lane_off(int) const { return false; }
    __device__ __forceinline__ void apply(int kt, f32x16& p0, f32x16& p1, int hi) const {
        const int k0 = kt * 64;
        if (k0 + 63 <= qmin && k0 >= qmax - (W - 1)) return;
#pragma unroll
        for (int r = 0; r < 16; ++r) { const int d = q - (k0 + crow(r, hi));
            p0[r] = ((unsigned)d < (unsigned)W) ? p0[r] : -INFINITY;
            p1[r] = ((unsigned)(d - 32) < (unsigned)W) ? p1[r] : -INFINITY; }
    }
};
struct MaskSel {
    int q, qmin, qmax; unsigned long long sel;
    __device__ __forceinline__ bool active(int kt) const { return (kt * 64 <= qmax) && __any((int)((sel >> kt) & 1ull)); }
    __device__ __forceinline__ bool lane_off(int kt) const { return ((sel >> kt) & 1ull) == 0ull; }
    __device__ __forceinline__ void apply(int kt, f32x16& p0, f32x16& p1, int hi) const {
        const int k0 = kt * 64;
        if (k0 + 63 <= qmin) return;
#pragma unroll
        for (int r = 0; r < 16; ++r) { const int d = q - (k0 + crow(r, hi));
            p0[r] = (d >= 0) ? p0[r] : -INFINITY;
            p1[r] = (d >= 32) ? p1[r] : -INFINITY; }
    }
};

__device__ __forceinline__ void imp_mma(f32x16& oi, bf16x8 pa, int kt, int ks, int cb, int r32, int hi) {
    int rl = r32; asm volatile("" : "+v"(rl));
    const int d0 = (64 * kt + 16 * ks + 8 * hi) - 4 * (32 * cb + rl);
    u32x4 w;
#pragma unroll
    for (int e2 = 0; e2 < 4; ++e2) {
        const int da = d0 + 2 * e2, db = da + 1;
        const unsigned lo = ((unsigned)(da + 1) <= 4u) ? 0x3F80u : 0u, hh = ((unsigned)(db + 1) <= 4u) ? 0x3F80u : 0u;
        w[e2] = lo | (hh << 16);
    }
    oi = __builtin_amdgcn_mfma_f32_32x32x16_bf16(pa, *reinterpret_cast<bf16x8*>(&w), oi, 0, 0, 0);
}

template <int MODE, bool QREG, class MaskF>
__device__ __forceinline__ void attn_stream(char* lds, const bf16x8 (&qr)[8], const bf16* qp, const bf16* Kb, const bf16* Vb, long ldk, int kt0, int kt1, const MaskF& mf,
                                            f32x16 (&o)[4], float& m_reg, float& l_reg, float inv_l, f32x16& oi0, f32x16& oi1) {
    int tid = threadIdx.x; asm volatile("" : "+v"(tid));
    const int wid = __builtin_amdgcn_readfirstlane(tid >> 6), lane = tid & 63, r32 = lane & 31, hi = lane >> 5;
    char* V_lds = lds; char* K_lds = lds + 2 * SHM_V;
    float* al_l = (float*)(lds + ATT_WS_OFF) + wid * 64;
    const int sr = tid >> 4, sc = (tid & 15) * 8, vst0 = v_st(sr, sc), vst1 = v_st(32 + sr, sc);
    const int vb0 = (int)(uintptr_t)V_lds + v_rd_base(lane);
    bf16x8 vs0 = {}, vs1 = {}, ks0, ks1;
    if (kt1 < kt0) return;
#define SLOAD(kt_) do { const long r0_ = (long)((kt_) * 64 + sr) * ldk + sc, r1_ = r0_ + 32 * ldk; ks0 = *(const bf16x8*)(Kb + r0_); ks1 = *(const bf16x8*)(Kb + r1_); \
    if (MODE == 0 || MODE == 2) { vs0 = *(const bf16x8*)(Vb + r0_); vs1 = *(const bf16x8*)(Vb + r1_); } } while (0)
#define SWRITE(b_) do { *(bf16x8*)(K_lds + (b_) * SHM_K + KSWZ(sr, sc * 2)) = ks0; *(bf16x8*)(K_lds + (b_) * SHM_K + KSWZ(32 + sr, sc * 2)) = ks1; \
    if (MODE == 0 || MODE == 2) { *(bf16x8*)(V_lds + (b_) * SHM_V + vst0) = vs0; *(bf16x8*)(V_lds + (b_) * SHM_V + vst1) = vs1; } } while (0)
    SLOAD(kt0); SWRITE(0); __syncthreads();
    for (int kt = kt0; kt <= kt1; ++kt) {
        const int buf = (kt - kt0) & 1;
        if (kt < kt1) SLOAD(kt + 1);
        if (mf.active(kt)) {
            f32x16 p0, p1;
            if (QREG) qkt(p0, p1, K_lds + buf * SHM_K, qr, r32, hi); else qkt_g(p0, p1, K_lds + buf * SHM_K, qp, r32, hi);
            mf.apply(kt, p0, p1, hi);
            if (MODE >= 2) {
                const float mfix = m_reg - __builtin_amdgcn_logf(inv_l);
#pragma unroll
                for (int r = 0; r < 16; r += 2) { const f32x2_t a = (f32x2_t){p0[r], p0[r + 1]} - mfix, bq = (f32x2_t){p1[r], p1[r + 1]} - mfix;
                    p0[r] = __builtin_amdgcn_exp2f(a.x); p0[r + 1] = __builtin_amdgcn_exp2f(a.y); p1[r] = __builtin_amdgcn_exp2f(bq.x); p1[r + 1] = __builtin_amdgcn_exp2f(bq.y); }
                bf16x8 pa0, pa1, pa2, pa3; p_to_frags(p0, p1, pa0, pa1, pa2, pa3);
                if (MODE == 2) pv_d0(o, vb0 + buf * SHM_V, pa0, pa1, pa2, pa3);
                else if (kt < 2) { imp_mma(oi0, pa0, kt, 0, 0, r32, hi); imp_mma(oi0, pa1, kt, 1, 0, r32, hi); imp_mma(oi0, pa2, kt, 2, 0, r32, hi); imp_mma(oi0, pa3, kt, 3, 0, r32, hi);
                              if (kt == 1) imp_mma(oi1, pa3, kt, 3, 1, r32, hi); }
                else { imp_mma(oi1, pa0, kt, 0, 1, r32, hi); imp_mma(oi1, pa1, kt, 1, 1, r32, hi); imp_mma(oi1, pa2, kt, 2, 1, r32, hi); imp_mma(oi1, pa3, kt, 3, 1, r32, hi); }
            } else {
                float pmax = p0[0];
#pragma unroll
                for (int r = 1; r < 16; ++r) pmax = fmaxf(pmax, p0[r]);
#pragma unroll
                for (int r = 0; r < 16; ++r) pmax = fmaxf(pmax, p1[r]);
                const bool off = mf.lane_off(kt);
                pmax = off ? -INFINITY : pmax;
                pmax = pair_max(pmax);
                float mn = m_reg, alpha = 1.f;
                if (!__all(pmax - m_reg <= 8.0f)) {
                    mn = fmaxf(m_reg, pmax); alpha = __builtin_amdgcn_exp2f(m_reg - mn); m_reg = mn; }
                const float mne = off ? INFINITY : mn;
                f32x2_t ps2 = {0.f, 0.f};
#pragma unroll
                for (int r = 0; r < 16; r += 2) { const f32x2_t a = (f32x2_t){p0[r], p0[r + 1]} - mne, bq = (f32x2_t){p1[r], p1[r + 1]} - mne;
                    p0[r] = __builtin_amdgcn_exp2f(a.x); p0[r + 1] = __builtin_amdgcn_exp2f(a.y); p1[r] = __builtin_amdgcn_exp2f(bq.x); p1[r + 1] = __builtin_amdgcn_exp2f(bq.y);
                    ps2 += (f32x2_t){p0[r], p0[r + 1]} + (f32x2_t){p1[r], p1[r + 1]}; }
                float ps = pair_sum(ps2.x + ps2.y);
                l_reg = l_reg * alpha + ps;
                if (MODE == 0) {
                    if (__any(alpha < 1.f)) {
                        if (hi == 0) al_l[r32] = alpha;
                        asm volatile("s_waitcnt lgkmcnt(0)" ::: "memory");
#pragma unroll
                        for (int r = 0; r < 16; ++r) { const float a = al_l[crow(r, hi)];
#pragma unroll
                            for (int d = 0; d < 4; ++d) o[d][r] *= a; }
                    }
                    bf16x8 pa0, pa1, pa2, pa3; p_to_frags(p0, p1, pa0, pa1, pa2, pa3);
                    pv_d0(o, vb0 + buf * SHM_V, pa0, pa1, pa2, pa3);
                }
            }
        }
        if (kt < kt1) SWRITE(buf ^ 1);
        __syncthreads();
    }
#undef SLOAD
#undef SWRITE
}
__device__ __forceinline__ void load_q(bf16x8 (&qr)[8], const bf16* qp) {
#pragma unroll
    for (int d0 = 0; d0 < 8; ++d0) qr[d0] = *(const bf16x8*)(qp + d0 * 16);
}
__device__ __forceinline__ void row_fac(float* al_l, float fac, int r32, int hi, float (&f)[16]) {
    asm volatile("s_waitcnt lgkmcnt(0)" ::: "memory");
    if (hi == 0) al_l[r32] = fac;
    asm volatile("s_waitcnt lgkmcnt(0)" ::: "memory");
#pragma unroll
    for (int r = 0; r < 16; ++r) f[r] = al_l[crow(r, hi)];
    asm volatile("s_waitcnt lgkmcnt(0)" ::: "memory");
}
__device__ __forceinline__ int next_unit(char* lds, unsigned* ctr) {
    volatile int* uw = (volatile int*)(lds + ATT_UNIT_OFF);
    asm volatile("s_waitcnt lgkmcnt(0)\n\ts_barrier" ::: "memory");
    if (threadIdx.x == 0) *uw = (int)atomicAdd(ctr, 1u);
    asm volatile("s_waitcnt lgkmcnt(0)\n\ts_barrier" ::: "memory");
    return __builtin_amdgcn_readfirstlane(*uw);
}

__device__ __forceinline__ void mem_attn_unit(char* lds, int unit, const bf16* ZM, const bf16* MKV, bf16* O, int ldo, int ocol0) {
    int tid = threadIdx.x; asm volatile("" : "+v"(tid));
    const int wid = __builtin_amdgcn_readfirstlane(tid >> 6), lane = tid & 63, r32 = lane & 31, hi = lane >> 5;
    const int b = unit >> 6, h = (unit >> 4) & 3, qb = unit & 15;
    const int t = qb * 256 + wid * 32 + r32;
    bf16x8 qr[8]; load_q(qr, ZM + ((size_t)(b * S + t)) * 512 + h * 128 + hi * 8);
    f32x16 o[4] = {zero16(), zero16(), zero16(), zero16()}; float m_reg = -1e30f, l_reg = 0.f; f32x16 d0_, d1_;
    const bf16* Kb = MKV + (size_t)(b * 256) * 1024 + h * 128;
    MaskNone mk;
    attn_stream<0, true>(lds, qr, nullptr, Kb, Kb + 512, 1024, 0, 3, mk, o, m_reg, l_reg, 0.f, d0_, d1_);
    float f[16]; row_fac((float*)(lds + ATT_WS_OFF) + wid * 64, l_reg > 0.f ? 1.0f / l_reg : 0.f, r32, hi, f);
    bf16* Ow = O + ((size_t)(b * S + qb * 256 + wid * 32)) * ldo + ocol0 + h * 128;
#pragma unroll
    for (int r = 0; r < 16; ++r) { const int orow = crow(r, hi);
#pragma unroll
        for (int d = 0; d < 4; ++d) Ow[(size_t)orow * ldo + d * 32 + r32] = (bf16)(cvtpk(o[d][r] * f[r], 0.f) & 0xffffu); }
}

__device__ __forceinline__ void nsa_cmp_unit(char* lds, int unit, unsigned char* ws, float* cmp_part) {
    int tid = threadIdx.x; asm volatile("" : "+v"(tid));
    const int wid = __builtin_amdgcn_readfirstlane(tid >> 6), lane = tid & 63, r32 = lane & 31, hi = lane >> 5;
    const int qb = 31 - (unit >> 3), b = (unit >> 1) & 3, g = unit & 1;
    const int slab = wid & 3, ht = wid >> 2;
    const int t = qb * 128 + slab * 32 + r32;
    const bf16* Q = (const bf16*)(ws + WS_OVL + OA_Q); bf16* O = (bf16*)cmp_part;
    const float* gates = (const float*)(ws + WS_GATES);
    const bf16* Kb = (const bf16*)(ws + WS_KC) + (size_t)(b * 256 * 2 + g) * 128;
    const bf16* Vb = (const bf16*)(ws + WS_VC) + (size_t)(b * 256 * 2 + g) * 128;
    float* al_l = (float*)(lds + ATT_WS_OFF) + wid * 64;
    MaskBand mk; mk.q = (t - 31) >> 4; mk.W = 1 << 30; mk.qmin = __builtin_amdgcn_readlane(mk.q, 0); mk.qmax = __builtin_amdgcn_readlane(mk.q, 31);
    LAS float* imp = (LAS float*)lds + 18432;
#pragma unroll
    for (int r = 0; r < 16; ++r) { const int q = slab * 32 + crow(r, hi); imp[(ht * 128 + q) * 64 + r32] = 0.f; imp[(ht * 128 + q) * 64 + 32 + r32] = 0.f; }
#pragma unroll 1
    for (int hh = 0; hh < 3; ++hh) {
        f32x16 oi0 = zero16(), oi1 = zero16();
        const int hq = g * 6 + ht * 3 + hh;
        const bf16* qp = Q + ((size_t)(b * S + t)) * 1536 + hq * 128 + hi * 8;
        bf16x8 qr[8] = {};
        f32x16 o[4] = {zero16(), zero16(), zero16(), zero16()}; float m_reg = -1e30f, l_reg = 0.f;
        attn_stream<1, false>(lds, qr, qp, Kb, Vb, 256, 0, 3, mk, o, m_reg, l_reg, 0.f, oi0, oi1);
        const float inv = l_reg > 0.f ? 1.0f / l_reg : 0.f;
        attn_stream<2, false>(lds, qr, qp, Kb, Vb, 256, 0, 3, mk, o, m_reg, l_reg, inv, oi0, oi1);
        attn_stream<3, false>(lds, qr, qp, Kb, Vb, 256, 0, 3, mk, o, m_reg, l_reg, inv, oi0, oi1);
#pragma unroll
        for (int r = 0; r < 16; ++r) { const int q = slab * 32 + crow(r, hi); imp[(ht * 128 + q) * 64 + r32] += oi0[r]; imp[(ht * 128 + q) * 64 + 32 + r32] += oi1[r]; }
        float f[16]; row_fac(al_l, gates[((size_t)(b * S + t)) * 36 + hq * 3 + 0], r32, hi, f);
        u32x4* Pc = (u32x4*)O + ((size_t)((((b * 2 + g) * 32 + qb) * 6 + ht * 3 + hh) * 4 + slab)) * 512 + lane;
#pragma unroll
        for (int d = 0; d < 4; ++d)
#pragma unroll
            for (int r = 0; r < 16; r += 8) { u32x4 w; w.x = cvtpk(o[d][r] * f[r], o[d][r + 1] * f[r + 1]); w.y = cvtpk(o[d][r + 2] * f[r + 2], o[d][r + 3] * f[r + 3]);
                w.z = cvtpk(o[d][r + 4] * f[r + 4], o[d][r + 5] * f[r + 5]); w.w = cvtpk(o[d][r + 6] * f[r + 6], o[d][r + 7] * f[r + 7]); Pc[(d * 2 + (r >> 3)) * 64] = w; }
    }
    __syncthreads();
    unsigned long long* SEL = (unsigned long long*)(ws + WS_SEL) + (size_t)(b * 2 + g) * S;
#pragma unroll 1
    for (int qi = 0; qi < 16; ++qi) {
        int q = wid * 16 + qi; asm volatile("" : "+v"(q));
        const int tq = qb * 128 + q, cur = tq >> 6, j = lane;
        const float v = imp[q * 64 + j] + imp[(128 + q) * 64 + j];
        const bool forced = (j == 0) || (j == cur) || (j == cur - 1), elig = (j <= cur);
        const float sc = forced ? 1e9f : (elig ? v : -1e9f);
        int cnt = 0;
#pragma unroll 4
        for (int i = 0; i < 64; ++i) { const float other = __uint_as_float(__builtin_amdgcn_readlane(__float_as_uint(sc), i));
            cnt += ((other > sc) || (other == sc && i < j)) ? 1 : 0; }
        const unsigned long long msk = __ballot((cnt < 16) && elig);
        if (lane == 0) SEL[tq] = msk;
    }
    __syncthreads();
}

__device__ __forceinline__ void nsa_main_unit(char* lds, int unit, unsigned char* ws, const float* cmp_part) {
    int tid = threadIdx.x; asm volatile("" : "+v"(tid));
    const int wid = __builtin_amdgcn_readfirstlane(tid >> 6), lane = tid & 63, r32 = lane & 31, hi = lane >> 5;
    const int qb = 31 - unit / 24, rem = unit % 24, b = rem / 6, g = (rem / 3) & 1, hp = rem % 3;
    const int slab = wid & 3, hq = g * 6 + hp * 2 + (wid >> 2);
    const int t = qb * 128 + slab * 32 + r32;
    const bf16* Q = (const bf16*)(ws + WS_OVL + OA_Q); bf16* O = (bf16*)(ws + WS_OVL + OA_O);
    const bf16* KV = (const bf16*)(ws + WS_OVL + OA_KV) + (size_t)(b * S) * 1536;
    const float* gates = (const float*)(ws + WS_GATES) + ((size_t)(b * S + t)) * 36 + hq * 3;
    float* al_l = (float*)(lds + ATT_WS_OFF) + wid * 64;
    const unsigned long long sel = ((const unsigned long long*)(ws + WS_SEL))[(size_t)(b * 2 + g) * S + t];
    bf16x8 qr[8]; load_q(qr, Q + ((size_t)(b * S + t)) * 1536 + hq * 128 + hi * 8);
    const int tmin = __builtin_amdgcn_readlane(t, 0), tmax = __builtin_amdgcn_readlane(t, 31);
    f32x16 dm0, dm1;
    {
        f32x16 o[4] = {zero16(), zero16(), zero16(), zero16()}; float m_reg = -1e30f, l_reg = 0.f;
        MaskBand mk; mk.q = t; mk.W = 512; mk.qmin = tmin; mk.qmax = tmax;
        const int lo = qb * 128 - 511, kt0 = lo <= 0 ? 0 : (lo >> 6);
        attn_stream<0, true>(lds, qr, nullptr, KV + (8 + g) * 128, KV + (10 + g) * 128, 1536, kt0, 2 * qb + 1, mk, o, m_reg, l_reg, 0.f, dm0, dm1);
        float f[16]; row_fac(al_l, l_reg > 0.f ? gates[2] / l_reg : 0.f, r32, hi, f);
        LAS u32x4* wsc = (LAS u32x4*)((LAS unsigned char*)lds + 69632 + tid * 128);
#pragma unroll
        for (int d = 0; d < 4; ++d)
#pragma unroll
            for (int r = 0; r < 16; r += 8) { u32x4 w; w.x = cvtpk(o[d][r] * f[r], o[d][r + 1] * f[r + 1]); w.y = cvtpk(o[d][r + 2] * f[r + 2], o[d][r + 3] * f[r + 3]);
                w.z = cvtpk(o[d][r + 4] * f[r + 4], o[d][r + 5] * f[r + 5]); w.w = cvtpk(o[d][r + 6] * f[r + 6], o[d][r + 7] * f[r + 7]); wsc[d * 2 + (r >> 3)] = w; }
    }
    {
        f32x16 o[4] = {zero16(), zero16(), zero16(), zero16()}; float m_reg = -1e30f, l_reg = 0.f;
        MaskSel mk; mk.q = t; mk.qmin = tmin; mk.qmax = tmax; mk.sel = sel;
        attn_stream<0, true>(lds, qr, nullptr, KV + (4 + g) * 128, KV + (6 + g) * 128, 1536, 0, 2 * qb + 1, mk, o, m_reg, l_reg, 0.f, dm0, dm1);
        float f[16]; row_fac(al_l, l_reg > 0.f ? gates[1] / l_reg : 0.f, r32, hi, f);
        bf16* Ow = O + ((size_t)(b * S + qb * 128 + slab * 32)) * 2048 + hq * 128;
        const u32x4* Pc = (const u32x4*)cmp_part + ((size_t)((((b * 2 + g) * 32 + qb) * 6 + hp * 2 + (wid >> 2)) * 4 + slab)) * 512 + lane;
        u32x4 pc[8];
#pragma unroll
        for (int j = 0; j < 8; ++j) pc[j] = Pc[j * 64];
#pragma unroll
        for (int d = 0; d < 4; ++d)
#pragma unroll
            for (int r = 0; r < 16; r += 8) { const u32x4 w = ((const LAS u32x4*)((LAS unsigned char*)lds + 69632 + tid * 128))[d * 2 + (r >> 3)];
#pragma unroll
                for (int e = 0; e < 4; ++e) { const unsigned pw = pc[d * 2 + (r >> 3)][e];
                    o[d][r + 2 * e] = o[d][r + 2 * e] * f[r + 2 * e] + __uint_as_float(w[e] << 16) + __uint_as_float(pw << 16);
                    o[d][r + 2 * e + 1] = o[d][r + 2 * e + 1] * f[r + 2 * e + 1] + __uint_as_float(w[e] & 0xffff0000u) + __uint_as_float(pw & 0xffff0000u); } }
#pragma unroll
        for (int r = 0; r < 16; ++r) { const int orow = crow(r, hi);
#pragma unroll
            for (int d = 0; d < 4; ++d) { const size_t off = (size_t)orow * 2048 + d * 32 + r32;
                Ow[off] = (bf16)(cvtpk(o[d][r], 0.f) & 0xffffu); } }
    }
}

constexpr size_t OB_PO = OB_O + (size_t)M * 1024 * 2;
static_assert(OB_PO + 3 * (size_t)M * 512 * 2 <= OVL_BYTES, "dilated partials");
__device__ __forceinline__ void dil_unit(char* lds, int unit, unsigned char* ws) {
    int tid = threadIdx.x; asm volatile("" : "+v"(tid));
    const int wid = __builtin_amdgcn_readfirstlane(tid >> 6), lane = tid & 63, r32 = lane & 31, hi = lane >> 5;
    const int gi = unit >> 8, rem = unit & 255, b = rem >> 6, hg = (rem >> 4) & 3;
    const int sh = 2 * gi, nblk = 16 >> sh, blk = rem & (nblk - 1), cls = (rem & 15) >> (4 - sh);
    const int qi = 256 * blk + wid * 32 + r32, t = cls + (qi << sh);
    const bf16* Q = (const bf16*)(ws + WS_OVL + OB_Q); const bf16* KS = (const bf16*)(ws + WS_OVL + OB_KS); const bf16* VS = (const bf16*)(ws + WS_OVL + OB_VS);
    bf16* PO = (bf16*)(ws + WS_OVL + OB_PO) + (size_t)gi * M * 512;
    float* LSE = (float*)(ws + WS_OSCR) + (size_t)gi * M * 4;
    f32x16 o[4] = {zero16(), zero16(), zero16(), zero16()}; float m_reg = -1e30f, l_reg = 0.f; f32x16 dm0, dm1;
    bf16x8 qr[8]; load_q(qr, Q + ((size_t)(b * S + t)) * 1536 + (gi * 4 + hg) * 128 + hi * 8);
    MaskBand mk; mk.q = qi; mk.W = 129; mk.qmin = __builtin_amdgcn_readlane(mk.q, 0); mk.qmax = __builtin_amdgcn_readlane(mk.q, 31);
    const size_t base = ((size_t)(b * S + cls)) * 512 + hg * 128;
    const int kt0 = 4 * blk - 2 < 0 ? 0 : 4 * blk - 2;
    attn_stream<0, true>(lds, qr, nullptr, KS + base, VS + base, (long)512 << sh, kt0, 4 * blk + 3, mk, o, m_reg, l_reg, 0.f, dm0, dm1);
    if (hi == 0) LSE[((size_t)(b * S + t)) * 4 + hg] = m_reg + __builtin_amdgcn_logf(l_reg);
    float f[16]; row_fac((float*)(lds + ATT_WS_OFF) + wid * 64, l_reg > 0.f ? 1.0f / l_reg : 0.f, r32, hi, f);
    bf16* Ow = PO + ((size_t)(b * S + cls + ((256 * blk + wid * 32) << sh))) * 512 + hg * 128;
    const size_t rstride = (size_t)512 << sh;
#pragma unroll
    for (int r = 0; r < 16; ++r) { const int orow = crow(r, hi);
#pragma unroll
        for (int d = 0; d < 4; ++d) Ow[(size_t)orow * rstride + d * 32 + r32] = (bf16)(cvtpk(o[d][r] * f[r], 0.f) & 0xffffu); }
}
__device__ __forceinline__ void dil_merge(unsigned char* ws) {
    const bf16* PO = (const bf16*)(ws + WS_OVL + OB_PO); const float* LSE = (const float*)(ws + WS_OSCR);
    bf16* O = (bf16*)(ws + WS_OVL + OB_O);
    int tm = threadIdx.x; asm volatile("" : "+v"(tm));
    for (int e = blockIdx.x * NTHR + tm; e < M * 64; e += gridDim.x * NTHR) {
        const int tok = e >> 6, c8 = e & 63, hg = c8 >> 4;
        const float l0 = LSE[(size_t)tok * 4 + hg], l1 = LSE[(size_t)M * 4 + (size_t)tok * 4 + hg], l2 = LSE[(size_t)2 * M * 4 + (size_t)tok * 4 + hg];
        const float mx = fmaxf(l0, fmaxf(l1, l2));
        float w0 = __builtin_amdgcn_exp2f(l0 - mx), w1 = __builtin_amdgcn_exp2f(l1 - mx), w2 = __builtin_amdgcn_exp2f(l2 - mx);
        const float inv = 1.0f / (w0 + w1 + w2); w0 *= inv; w1 *= inv; w2 *= inv;
        const u32x4 a = *(const u32x4*)(PO + (size_t)tok * 512 + c8 * 8), bq = *(const u32x4*)(PO + (size_t)M * 512 + (size_t)tok * 512 + c8 * 8), cq = *(const u32x4*)(PO + (size_t)2 * M * 512 + (size_t)tok * 512 + c8 * 8);
        u32x4 r;
#pragma unroll
        for (int i = 0; i < 4; ++i) {
            const float lo = w0 * __uint_as_float(a[i] << 16) + w1 * __uint_as_float(bq[i] << 16) + w2 * __uint_as_float(cq[i] << 16);
            const float hh = w0 * __uint_as_float(a[i] & 0xffff0000u) + w1 * __uint_as_float(bq[i] & 0xffff0000u) + w2 * __uint_as_float(cq[i] & 0xffff0000u);
            r[i] = cvtpk(lo, hh); }
        *(u32x4*)(O + (size_t)tok * 1024 + c8 * 8) = r;
    }
}

__device__ __forceinline__ void compress_unit(char* lds, int unit, unsigned char* ws) {
    int tid = threadIdx.x; asm volatile("" : "+v"(tid));
    const int wid = __builtin_amdgcn_readfirstlane(tid >> 6), lane = tid & 63, r32 = lane & 31, hi = lane >> 5;
    const int kv = unit >> 6, g = (unit >> 5) & 1, mt = unit & 31, b = mt >> 3, c0 = (mt & 7) * 32;
    const bf16* KVp = (const bf16*)(ws + WS_OVL + OA_KV);
    const bf16* W1t = (const bf16*)(ws + (kv ? WS_W1V : WS_W1K));
    const bf16* W2t = (const bf16*)(ws + (kv ? WS_W2V : WS_W2K));
    const float* bias = (const float*)(ws + WS_BIAS) + kv * 256;
    f32x16 acc = zero16();
    const int c = c0 + r32, n = 32 * wid + r32;
    const bf16* bp = W1t + (size_t)n * 4096 + hi * 8;
    bf16x8 fa[2][8], fb[2][8];
#define CLOAD(s_, l_) do { int tok_ = 16 * c + (l_); tok_ = tok_ < S ? tok_ : S - 1; \
        const bf16* ap_ = KVp + ((size_t)(b * S + tok_)) * 1536 + (kv * 2 + g) * 128 + hi * 8; \
        _Pragma("unroll") for (int ks = 0; ks < 8; ++ks) { fa[s_][ks] = *(const bf16x8*)(ap_ + ks * 16); fb[s_][ks] = *(const bf16x8*)(bp + (l_) * 128 + ks * 16); } } while (0)
#define CMMA(s_) do { _Pragma("unroll") for (int ks = 0; ks < 8; ++ks) acc = __builtin_amdgcn_mfma_f32_32x32x16_bf16(fa[s_][ks], fb[s_][ks], acc, 0, 0, 0); } while (0)
    CLOAD(0, 0);
#pragma unroll 1
    for (int l = 0; l < 32; l += 2) {
        CLOAD(1, l + 1);
        CMMA(0);
        if (l + 2 < 32) CLOAD(0, l + 2);
        CMMA(1);
    }
#undef CLOAD
#undef CMMA
    bf16* hid = (bf16*)lds;
    const float bn = bias[n];
#pragma unroll
    for (int r = 0; r < 16; ++r) { const float z = acc[r] + bn; const float sg = z / (1.0f + __expf(-z));
        hid[crow(r, hi) * 264 + n] = (bf16)(cvtpk(sg, 0.f) & 0xffffu); }
    __syncthreads();
#ifdef CX_DUMP_HID
    { bf16* dd = (bf16*)(ws + WS_OSCR) + (size_t)unit * 8192; for (int e = tid; e < 8192; e += NTHR) dd[e] = hid[(e >> 8) * 264 + (e & 255)]; }
#endif
    if (wid < 4) {
        f32x16 a2 = zero16();
        const int n2 = 32 * wid + r32;
#pragma unroll
        for (int ks = 0; ks < 16; ++ks) {
            const bf16x8 a = *(const bf16x8*)(hid + r32 * 264 + ks * 16 + hi * 8), bb = *(const bf16x8*)(W2t + (size_t)n2 * 256 + ks * 16 + hi * 8);
            a2 = __builtin_amdgcn_mfma_f32_32x32x16_bf16(a, bb, a2, 0, 0, 0);
        }
        bf16* outp = (bf16*)(ws + (kv ? WS_VC : WS_KC));
#pragma unroll
        for (int r = 0; r < 16; ++r) { const int cc = c0 + crow(r, hi);
            outp[((size_t)(b * 256 + cc) * 2 + g) * 128 + n2] = (cc == 255) ? (bf16)0 : (bf16)(cvtpk(a2[r], 0.f) & 0xffffu); }
    }
    __syncthreads();
}

__global__ void __launch_bounds__(NTHR) fwd_kernel(Params p) {
    extern __shared__ __attribute__((aligned(16))) unsigned char lds[];
    unsigned char* ws = p.ws;
    const int tid = threadIdx.x;
    unsigned* ctl = (unsigned*)(ws + WS_CTL);
    for (int sq_ = p.ph_lo; sq_ < p.ph_hi; ++sq_) {
        const int ph = sq_ <= 9 ? sq_ : (sq_ == 10 ? 14 : sq_ - 1);
        const int rep = 0;
        const bool is_gemm = (PH_MASK & 1) && ((ph == 1) || (ph >= 5 && ph <= 8) || (ph >= 10 && ph <= 12));
        if (is_gemm) {
            const int ngem = (ph == 1) ? 3 : 1;
            for (int gi = 0; gi < ngem; ++gi) {
                pg8::Gemm g; pg8::EpiG E; int corder = (int)blockIdx.x;
                E.mode = 0; E.ss = nullptr; E.ssq = nullptr; E.res = nullptr; E.resb = nullptr; E.hout = nullptr; E.hb = nullptr; E.ssout = nullptr; E.o0 = E.o1 = E.o2 = E.o3 = nullptr;
                E.gates = nullptr; E.gbias = nullptr; E.cosT = (const float*)(ws + WS_COS); E.sinT = (const float*)(ws + WS_SIN);
                const pg8::bf16_t* HBp = (const pg8::bf16_t*)(ws + WS_HB);
                if (ph == 1 && gi == 0) {
                    g = pg8::Gemm{HBp, (const pg8::bf16_t*)(ws + WS_WINA), M, 3840, 2048};
                    E.mode = pg8::EM_INA; E.ss = (const float*)(ws + WS_SS0); E.o0 = (pg8::bf16_t*)(ws + WS_OVL + OA_Q); E.o1 = (pg8::bf16_t*)(ws + WS_OVL + OA_KV); E.o2 = (pg8::bf16_t*)(ws + WS_OVL + OA_ZM);
                    E.gates = (float*)(ws + WS_GATES); E.gbias = p.in[4];
                } else if (ph == 1) {
                    g = pg8::Gemm{(const pg8::bf16_t*)(ws + WS_MEMB), (const pg8::bf16_t*)(ws + (gi == 1 ? WS_WMEMA : WS_WMEMB)), 1024, 1024, 2048};
                    E.mode = pg8::EM_MEMKV; E.ss = (const float*)(ws + WS_SSMEM); E.o0 = (pg8::bf16_t*)(ws + (gi == 1 ? WS_MKVA : WS_MKVB));
                    corder = ((int)blockIdx.x + (int)gridDim.x - (gi == 1 ? 192 : 208)) % (int)gridDim.x;
                } else if (ph == 5) {
                    g = pg8::Gemm{(const pg8::bf16_t*)(ws + WS_OVL + OA_O), (const pg8::bf16_t*)(ws + WS_WOA), M, 2048, 2048};
                    E.mode = pg8::EM_RES; E.resb = (const pg8::bf16_t*)(ws + WS_HB); E.hout = nullptr; E.hb = (pg8::bf16_t*)(ws + WS_HB); E.ssout = (unsigned long long*)(ws + WS_CTL + CTL_SS1);
                } else if (ph == 6 || ph == 11) {
                    g = pg8::Gemm{HBp, (const pg8::bf16_t*)(ws + (ph == 6 ? WS_WGUA : WS_WGUB)), M, 11264, 2048};
                    E.mode = pg8::EM_GU; E.ssq = (const unsigned long long*)(ws + WS_CTL + (ph == 6 ? CTL_SS1 : CTL_SS3)); E.o0 = (pg8::bf16_t*)(ws + WS_OVL);
                } else if (ph == 7 || ph == 12) {
                    g = pg8::Gemm{(const pg8::bf16_t*)(ws + WS_OVL), (const pg8::bf16_t*)(ws + (ph == 7 ? WS_WDA : WS_WDB)), M, 2048, 5632};
                    E.mode = pg8::EM_RES; E.resb = (const pg8::bf16_t*)(ws + WS_HB); E.hout = nullptr; E.hb = (pg8::bf16_t*)(ws + WS_HB); E.ssout = (unsigned long long*)(ws + WS_CTL + (ph == 7 ? CTL_SS2 : CTL_SS4));
                } else if (ph == 8) {
                    g = pg8::Gemm{HBp, (const pg8::bf16_t*)(ws + WS_WINB), M, 3072, 2048};
                    E.mode = pg8::EM_INB; E.ssq = (const unsigned long long*)(ws + WS_CTL + CTL_SS2); E.o0 = (pg8::bf16_t*)(ws + WS_OVL + OB_Q); E.o2 = (pg8::bf16_t*)(ws + WS_OVL + OB_ZM);
                    E.o1 = (pg8::bf16_t*)(ws + WS_OVL + OB_KS); E.o3 = (pg8::bf16_t*)(ws + WS_OVL + OB_VS);
                } else {
                    g = pg8::Gemm{(const pg8::bf16_t*)(ws + WS_OVL + OB_O), (const pg8::bf16_t*)(ws + WS_WOB), M, 2048, 1024};
                    E.mode = pg8::EM_RES; E.resb = (const pg8::bf16_t*)(ws + WS_HB); E.hout = nullptr; E.hb = (pg8::bf16_t*)(ws + WS_HB); E.ssout = (unsigned long long*)(ws + WS_CTL + CTL_SS3);
                }
                pg8::StaticOrder So; So.init(g.M, g.N, (int)gridDim.x, corder);
                pg8::gemm_phase<pg8::EpiG, pg8::StaticOrder, true, true>((LAS unsigned char*)lds, g, So, E);
                __syncthreads();
            }
        } else if ((PH_MASK & 2) && ph == 0) {
            phase_prologue(p, lds);
        } else if ((PH_MASK & 4) && ph == 2) {
            for (int u = blockIdx.x; u < 128; u += gridDim.x) compress_unit((char*)lds, u, ws);
            for (;;) { const int u = next_unit((char*)lds, ctl + 192); if (u >= 256) break;
                mem_attn_unit((char*)lds, u, (const bf16*)(ws + WS_OVL + OA_ZM), (const bf16*)(ws + WS_MKVA), (bf16*)(ws + WS_OVL + OA_O), 2048, 1536); }
        } else if ((PH_MASK & 8) && ph == 3) {
            for (;;) { const int u = next_unit((char*)lds, ctl + 0 + rep); if (u >= 256) break; nsa_cmp_unit((char*)lds, u, ws, p.out); }
        } else if ((PH_MASK & 16) && ph == 4) {
            for (;;) { const int u = next_unit((char*)lds, ctl + 64 + rep); if (u >= 768) break; nsa_main_unit((char*)lds, u, ws, p.out); }
        } else if ((PH_MASK & 32) && ph == 9) {
            for (;;) { const int u = next_unit((char*)lds, ctl + 128 + rep); if (u >= 1024) break;
                if (u < 768) dil_unit((char*)lds, u, ws);
                else mem_attn_unit((char*)lds, u - 768, (const bf16*)(ws + WS_OVL + OB_ZM), (const bf16*)(ws + WS_MKVB), (bf16*)(ws + WS_OVL + OB_O), 1024, 512); }
        } else if (ph == 14) {
            dil_merge(ws);
        } else if ((PH_MASK & 64) && ph == 13) {
            int tl = threadIdx.x; asm volatile("" : "+v"(tl));
            const int lane = tl & 63, gw = blockIdx.x * 8 + (tl >> 6), NGW = gridDim.x * 8;
            const unsigned long long* ss4 = (const unsigned long long*)(ws + WS_CTL + CTL_SS4); const f32x4* gn = (const f32x4*)p.in[29] + lane;
            for (int m = gw; m < M; m += NGW) {
                const float rs = 1.0f / sqrtf((float)ss4[m] * 5.9604644775390625e-08f * (1.0f / 2048.0f) + 1e-6f);
                f32x4* xr = (f32x4*)(p.out + (size_t)m * DM) + lane;
                const u32x2v* hr = (const u32x2v*)((const bf16*)(ws + WS_HB) + (size_t)m * DM) + lane;
#pragma unroll
                for (int j = 0; j < 8; ++j) { const u32x2v w = hr[64 * j];
                    const f32x4 v = {__uint_as_float(w.x << 16), __uint_as_float(w.x & 0xffff0000u), __uint_as_float(w.y << 16), __uint_as_float(w.y & 0xffff0000u)};
                    xr[64 * j] = v * rs * gn[64 * j]; }
            }
        }
        if (sq_ + 1 < p.ph_hi) {
            asm volatile("s_waitcnt vmcnt(0) lgkmcnt(0)" ::: "memory");
            cg::this_grid().sync();
            __builtin_amdgcn_fence(__ATOMIC_ACQUIRE, "agent");
            asm volatile("s_waitcnt vmcnt(0)" ::: "memory");
        }
    }
}

#ifndef DBG_DUMP_N
#define DBG_DUMP_N (M * DM)
#endif
__global__ void __launch_bounds__(256) dbg_dump(const unsigned short* src, float* out, size_t n) {
    for (size_t i = (size_t)blockIdx.x * 256 + threadIdx.x; i < n; i += (size_t)gridDim.x * 256) { float v = bf2f(src[i % (size_t)(DBG_DUMP_N)]); if (!(fabsf(v) < 1e30f)) v = 12345.f; out[i] = v; }
}
extern "C" void kernel_launch(void* const* d_in, const int* in_sizes, int n_in, void* d_out, int out_size, void* d_ws, size_t ws_size, hipStream_t stream) {
    static int grid = 0;
    if (grid == 0) {
        if (n_in != 30 || in_sizes[0] != M * DM || out_size != M * DM || ws_size < WS_END) {
            fprintf(stderr, "kernel_launch: unexpected shapes: n_in %d in0 %d out %d ws %zu (need %zu)\n", n_in, n_in > 0 ? in_sizes[0] : -1, out_size, ws_size, (size_t)WS_END); grid = -1; return; }
        int dev = 0, cus = 0, per_cu = 0;
        if (hipGetDevice(&dev) != hipSuccess || hipDeviceGetAttribute(&cus, hipDeviceAttributeMultiprocessorCount, dev) != hipSuccess) { grid = -1; return; }
        if (hipFuncSetAttribute((const void*)fwd_kernel, hipFuncAttributeMaxDynamicSharedMemorySize, LDS_BYTES) != hipSuccess) { fprintf(stderr, "kernel_launch: hipFuncSetAttribute failed\n"); grid = -1; return; }
        if (hipOccupancyMaxActiveBlocksPerMultiprocessor(&per_cu, (const void*)fwd_kernel, NTHR, LDS_BYTES) != hipSuccess || per_cu < 1) { fprintf(stderr, "kernel_launch: occupancy query says %d\n", per_cu); per_cu = 1; }
        (void)hipGetLastError();
        grid = cus;
    }
    if (grid < 0) return;
    (void)hipMemsetAsync((char*)d_ws + WS_CTL, 0, CTL_BYTES, stream);
    Params prm{};
    for (int i = 0; i < 30; ++i) prm.in[i] = (const float*)d_in[i];
    prm.out = (float*)d_out; prm.ws = (unsigned char*)d_ws;
#if N_LAUNCH_MODE == 1
    prm.ph_lo = 0; prm.ph_hi = NPH + 1;
    void* args[] = {&prm};
    hipError_t e = hipLaunchCooperativeKernel((const void*)fwd_kernel, dim3(grid), dim3(NTHR), args, LDS_BYTES, stream);
    if (e != hipSuccess) fprintf(stderr, "kernel_launch: cooperative launch failed: %s (grid %d)\n", hipGetErrorString(e), grid);
#else
#ifndef DBG_STOP
#define DBG_STOP (NPH)
#endif
    for (int ph = 0; ph <= DBG_STOP; ++ph) {
        prm.ph_lo = ph; prm.ph_hi = ph + 1;
        hipLaunchKernelGGL(fwd_kernel, dim3(grid), dim3(NTHR), LDS_BYTES, stream, prm);
    }
#ifdef DBG_DUMP_OFF
    hipLaunchKernelGGL(dbg_dump, dim3(2048), dim3(256), 0, stream, (const unsigned short*)((unsigned char*)d_ws + (DBG_DUMP_OFF)), (float*)d_out, (size_t)M * DM);
#endif
    hipError_t e = hipPeekAtLastError();
    if (e != hipSuccess) fprintf(stderr, "kernel_launch: launch failed: %s\n", hipGetErrorName(e));
#endif
}
```

```cpp
#include <hip/hip_runtime.h>
#include <hip/hip_cooperative_groups.h>
#include <cstdio>
#include <cstdint>
namespace cg = cooperative_groups;
#ifndef N_LAUNCH_MODE
#define N_LAUNCH_MODE 1
#endif
namespace pg8 {
#define PG8_LAS __attribute__((address_space(3)))
typedef unsigned short bf16_t;
typedef short bf16x8 __attribute__((ext_vector_type(8)));
typedef float f32x4 __attribute__((ext_vector_type(4)));
typedef unsigned u32x4 __attribute__((ext_vector_type(4)));
constexpr int BM = 256, BK = 64, HALF = 128, HTB = HALF * BK * 2  , STAGE_BYTES = 8 * HTB, NXCD = 8, WGM = 8;

__host__ __device__ __forceinline__ int lds_byte(int r, int c) { const int st = (r >> 4) * 2 + (c >> 5), rr = r & 15, cc = c & 31, ob = rr * 64 + cc * 2; return st * 1024 + (ob ^ (((ob >> 9) & 1) << 5)); }
__host__ __device__ __forceinline__ void stage_rc(int b, int& R, int& C) { const int st = b / 1024, sb = b % 1024, swz = sb ^ (((sb >> 9) & 1) << 5); R = (st >> 1) * 16 + swz / 64; C = (st & 1) * 32 + (swz % 64) / 2; }
__host__ __device__ __forceinline__ int perm32(int rho) { const int n = rho >> 4, i = rho & 15; return 8 * (i >> 2) + 4 * n + (i & 3); }

struct Unit { int pm, pn; };
struct Gemm { const bf16_t* A; const bf16_t* Bt; int M, N, K; };

struct StaticOrder {
    int nM, nN, nwg, G, c;
    __host__ __device__ void init(int M, int N, int G_, int c_) { nM = M / BM; nN = N / BM; nwg = nM * nN; G = G_; c = c_; }
    __host__ __device__ bool next(int i, Unit& u) const {
        const long L = (long)i * G + c; if (L >= nwg) return false;
        int wgid = (int)L; { const int q = nwg / NXCD, r = nwg % NXCD, xcd = wgid % NXCD, off = wgid / NXCD; wgid = (xcd < r ? xcd * (q + 1) : r * (q + 1) + (xcd - r) * q) + off; }
        const int nig = WGM * nN, gid = wgid / nig, fm = gid * WGM, gsz = (nM - fm) < WGM ? (nM - fm) : WGM;
        u.pm = fm + ((wgid % nig) % gsz); u.pn = (wgid % nig) / gsz; return true;
    }
    __device__ __forceinline__ void a_ready(const Unit&) const {}
    __device__ __forceinline__ void done(const Unit&) const {}
};

typedef float f32x2c_t __attribute__((ext_vector_type(2))); typedef __bf16 bf16x2c_t __attribute__((ext_vector_type(2)));
__device__ __forceinline__ unsigned cvt_pk_bf16(float lo, float hi) { f32x2c_t v = {lo, hi}; bf16x2c_t b = __builtin_convertvector(v, bf16x2c_t); return __builtin_bit_cast(unsigned, b); }
typedef unsigned u32x2 __attribute__((ext_vector_type(2)));
enum { EM_INA = 0, EM_INB = 1, EM_MEMKV = 2, EM_RES = 3, EM_GU = 4 };
constexpr float QSCALE = 0.08838834764831845f * 1.4426950408889634f;
constexpr float EPSN = 1e-6f;
struct EpiG {
    static constexpr bool PERM = true, AFTER_DRAIN = false;
    int mode;
    const float* ss; const unsigned long long* ssq; const float* res; const bf16_t* resb; float* hout; bf16_t* hb; unsigned long long* ssout;
    bf16_t* o0; bf16_t* o1; bf16_t* o2; bf16_t* o3;
    float* gates; const float* gbias; const float* cosT; const float* sinT;
    __device__ __forceinline__ float rowss(size_t row) const { return ssq ? (float)ssq[row] * 5.9604644775390625e-08f : ss[row]; }
    __device__ __forceinline__ void operator()(const f32x4 (&acc)[2][2][4][2], const Unit& u, int wr, int wc, int fr, int fq) const {
        const int rowb = u.pm * BM + wr * 64 + fr;
        const int cl = wc * 32 + 8 * fq;
        if (mode == EM_RES) {
#pragma unroll
            for (int ai = 0; ai < 2; ++ai) {
                u32x4 rw[4][2];
#pragma unroll
                for (int m = 0; m < 4; ++m)
#pragma unroll
                    for (int bj = 0; bj < 2; ++bj) rw[m][bj] = *(const u32x4*)(resb + (size_t)(rowb + ai * HALF + m * 16) * 2048 + (size_t)(u.pn * BM + bj * HALF + cl));
#pragma unroll
                for (int m = 0; m < 4; ++m) {
                    const size_t row = (size_t)(rowb + ai * HALF + m * 16);
                    float sq = 0.f;
#pragma unroll
                    for (int bj = 0; bj < 2; ++bj) {
                        const size_t off = row * 2048 + (size_t)(u.pn * BM + bj * HALF + cl);
                        const u32x4 q = rw[m][bj];
                        const f32x4 r0 = (f32x4){__uint_as_float(q.x << 16), __uint_as_float(q.x & 0xffff0000u), __uint_as_float(q.y << 16), __uint_as_float(q.y & 0xffff0000u)};
                        const f32x4 r1 = (f32x4){__uint_as_float(q.z << 16), __uint_as_float(q.z & 0xffff0000u), __uint_as_float(q.w << 16), __uint_as_float(q.w & 0xffff0000u)};
                        const f32x4 h0 = r0 + acc[ai][bj][m][0], h1 = r1 + acc[ai][bj][m][1];
                        if (hout) { *(f32x4*)(hout + off) = h0; *(f32x4*)(hout + off + 4) = h1; }
                        u32x4 w; w.x = cvt_pk_bf16(h0[0], h0[1]); w.y = cvt_pk_bf16(h0[2], h0[3]); w.z = cvt_pk_bf16(h1[0], h1[1]); w.w = cvt_pk_bf16(h1[2], h1[3]);
                        if (hb) *(u32x4*)(hb + off) = w;
                        sq += (h0[0] * h0[0] + h0[1] * h0[1]) + (h0[2] * h0[2] + h0[3] * h0[3]) + (h1[0] * h1[0] + h1[1] * h1[1]) + (h1[2] * h1[2] + h1[3] * h1[3]);
                    }
                    sq += __shfl_xor(sq, 16); sq += __shfl_xor(sq, 32);
                    if (fq == 0) atomicAdd(ssout + row, (unsigned long long)(sq * 16777216.0f + 0.5f));
                }
            }
            return;
        }
        float rsv[8];
        {
            float ssv[8];
#pragma unroll
            for (int i = 0; i < 8; ++i) ssv[i] = rowss((size_t)(rowb + (i >> 2) * HALF + (i & 3) * 16));
#pragma unroll
            for (int i = 0; i < 8; ++i) rsv[i] = __builtin_amdgcn_rsqf(ssv[i] * (1.0f / 2048.0f) + EPSN);
        }
        if (mode == EM_GU) {
#pragma unroll
            for (int ai = 0; ai < 2; ++ai)
#pragma unroll
                for (int m = 0; m < 4; ++m) {
                    const size_t row = (size_t)(rowb + ai * HALF + m * 16);
                    const float rs = rsv[ai * 4 + m];
                    float a[8];
                    const float cexp = -rs * 1.4426950408889634f, rs2 = rs * rs;
#pragma unroll
                    for (int n = 0; n < 2; ++n) {
                        const f32x4 ag = acc[ai][0][m][n], au = acc[ai][1][m][n];
                        const f32x4 tt = ag * cexp;
                        f32x4 ee; ee[0] = __builtin_amdgcn_exp2f(tt[0]); ee[1] = __builtin_amdgcn_exp2f(tt[1]); ee[2] = __builtin_amdgcn_exp2f(tt[2]); ee[3] = __builtin_amdgcn_exp2f(tt[3]);
                        const f32x4 dd = ee + 1.0f;
                        f32x4 rr; rr[0] = __builtin_amdgcn_rcpf(dd[0]); rr[1] = __builtin_amdgcn_rcpf(dd[1]); rr[2] = __builtin_amdgcn_rcpf(dd[2]); rr[3] = __builtin_amdgcn_rcpf(dd[3]);
                        const f32x4 ov = ((ag * au) * rs2) * rr;
                        a[n * 4 + 0] = ov[0]; a[n * 4 + 1] = ov[1]; a[n * 4 + 2] = ov[2]; a[n * 4 + 3] = ov[3];
                    }
                    u32x4 w; w.x = cvt_pk_bf16(a[0], a[1]); w.y = cvt_pk_bf16(a[2], a[3]); w.z = cvt_pk_bf16(a[4], a[5]); w.w = cvt_pk_bf16(a[6], a[7]);
                    *(u32x4*)(o0 + row * 5632 + (size_t)(u.pn * HALF + cl)) = w;
                }
            return;
        }
        bf16_t* dst = o0; int ld = 1536, colbase = 0; bool rope = false, isgate = false; float scale = 1.f;
        const int pn = u.pn;
        if (mode == EM_INA) {
            if (pn < 6) { dst = o0; ld = 1536; colbase = pn * 256; rope = true; scale = QSCALE; }
            else if (pn < 12) { dst = o1; ld = 1536; colbase = (pn - 6) * 256; rope = (((pn - 6) & 1) == 0); }
            else if (pn < 14) { dst = o2; ld = 512; colbase = (pn - 12) * 256; scale = QSCALE; }
            else isgate = true;
        } else if (mode == EM_INB) {
            if (pn < 6) { dst = o0; ld = 1536; colbase = pn * 256; rope = true; scale = QSCALE; }
            else if (pn < 8) { dst = o2; ld = 512; colbase = (pn - 6) * 256; scale = QSCALE; }
            else if (pn < 10) { dst = o1; ld = 512; colbase = (pn - 8) * 256; rope = true; }
            else { dst = o3; ld = 512; colbase = (pn - 10) * 256; }
        } else { dst = o0; ld = 1024; colbase = pn * 256; }
        const int i4 = 4 * wc + fq;
#pragma unroll
        for (int ai = 0; ai < 2; ++ai)
#pragma unroll
            for (int m = 0; m < 4; ++m) {
                const size_t row = (size_t)(rowb + ai * HALF + m * 16);
                const float rs0 = rsv[ai * 4 + m];
                if (isgate) {
#pragma unroll
                    for (int n = 0; n < 2; ++n)
#pragma unroll
                        for (int j = 0; j < 4; ++j) { const int c = cl + 4 * n + j;
                            if (c < 36) { const float z = acc[ai][0][m][n][j] * rs0 + gbias[c]; gates[row * 36 + c] = __builtin_amdgcn_rcpf(1.0f + __builtin_amdgcn_exp2f(-z * 1.4426950408889634f)); } }
                    continue;
                }
                const float rs = rs0 * scale;
                if (rope) {
                    const int t = (int)(row & 4095);
                    const f32x4 c4 = *(const f32x4*)(cosT + t * 64 + 4 * i4), s4 = *(const f32x4*)(sinT + t * 64 + 4 * i4);
#pragma unroll
                    for (int bj = 0; bj < 2; ++bj) {
                        const f32x4 v0 = acc[ai][bj][m][0] * rs, v1 = acc[ai][bj][m][1] * rs;
                        const f32x4 lo = v0 * c4 - v1 * s4, hi = v1 * c4 + v0 * s4;
                        bf16_t* rp = dst + row * ld + colbase + bj * HALF + 4 * i4;
                        u32x2 wl, wh; wl.x = cvt_pk_bf16(lo[0], lo[1]); wl.y = cvt_pk_bf16(lo[2], lo[3]); wh.x = cvt_pk_bf16(hi[0], hi[1]); wh.y = cvt_pk_bf16(hi[2], hi[3]);
                        *(u32x2*)rp = wl; *(u32x2*)(rp + 64) = wh;
                    }
                } else {
#pragma unroll
                    for (int bj = 0; bj < 2; ++bj) {
                        const f32x4 v0 = acc[ai][bj][m][0] * rs, v1 = acc[ai][bj][m][1] * rs;
                        u32x4 w; w.x = cvt_pk_bf16(v0[0], v0[1]); w.y = cvt_pk_bf16(v0[2], v0[3]); w.z = cvt_pk_bf16(v1[0], v1[1]); w.w = cvt_pk_bf16(v1[2], v1[3]);
                        *(u32x4*)(dst + row * ld + colbase + bj * HALF + cl) = w;
                    }
                }
            }
    }
};
template <class Epi, class Sched, bool ALIGN_EPI = false, bool SP2 = false>
__device__ __forceinline__ void gemm_phase(PG8_LAS unsigned char* lds, const Gemm g, const Sched& S, const Epi& E) {
    int tid = threadIdx.x; asm volatile("" : "+v"(tid));
    const int wid = __builtin_amdgcn_readfirstlane(tid >> 6), lane = tid & 63, wr = wid >> 2, wc = wid & 3, fr = lane & 15, fq = lane >> 4;
    const int K = g.K, nt = K / BK;
    unsigned voffA[2], voffB[2];
#pragma unroll
    for (int i = 0; i < 2; ++i) { int R, C; stage_rc(tid * 16 + i * 8192, R, C); const int Rb = Epi::PERM ? ((R & ~31) + perm32(R & 31)) : R;
        voffA[i] = (unsigned)(R * K + C) * 2u; voffB[i] = (unsigned)(Rb * K + C) * 2u; }
    const size_t kstep = (size_t)(BK * 2);
    const size_t hstep = (size_t)HALF * K * 2;
    const size_t tstep = 2 * hstep;
    const unsigned ldsw = (unsigned)wid * 1024u;
    const int aoff = lds_byte(wr * 64 + fr, fq * 8), boff = lds_byte(wc * 32 + fr, fq * 8);
#define PG8_SA(b, h) (((b) * 2 + (h)) * HTB)
#define PG8_SB(b, h) ((4 + (b) * 2 + (h)) * HTB)
#define PG8_STAGE(bufoff, gbase, voff) do { _Pragma("unroll") for (int _i = 0; _i < 2; ++_i) \
        __builtin_amdgcn_global_load_lds((const unsigned*)((const char*)(gbase) + (voff)[_i]), (PG8_LAS unsigned*)(lds + (bufoff) + ldsw + _i * 8192), 16, 0, 0); } while (0)
#define PG8_LDA(dst, b, h) do { _Pragma("unroll") for (int m = 0; m < 4; ++m) _Pragma("unroll") for (int k = 0; k < 2; ++k) dst[m][k] = *(const PG8_LAS bf16x8*)(lds + PG8_SA(b, h) + aoff + m * 2048 + k * 1024); } while (0)
#define PG8_LDB(dst, b, h) do { _Pragma("unroll") for (int n = 0; n < 2; ++n) _Pragma("unroll") for (int k = 0; k < 2; ++k) dst[n][k] = *(const PG8_LAS bf16x8*)(lds + PG8_SB(b, h) + boff + n * 2048 + k * 1024); } while (0)
#define PG8_MMA(ai, bj, At, Bt) do { __builtin_amdgcn_s_setprio(1); _Pragma("unroll") for (int m = 0; m < 4; ++m) _Pragma("unroll") for (int n = 0; n < 2; ++n) _Pragma("unroll") for (int k = 0; k < 2; ++k) \
        acc[ai][bj][m][n] = __builtin_amdgcn_mfma_f32_16x16x32_bf16(Bt[n][k], At[m][k], acc[ai][bj][m][n], 0, 0, 0); __builtin_amdgcn_s_setprio(0); } while (0)
#define PG8_WAIT_V(n) asm volatile("s_waitcnt vmcnt(" #n ")" ::: "memory")
#define PG8_WAIT_L(n) asm volatile("s_waitcnt lgkmcnt(" #n ")" ::: "memory")
#define PG8_BAR __builtin_amdgcn_s_barrier()
#define PG8_SCHED __builtin_amdgcn_sched_barrier(0)
    Unit cur, nxt; int ui = 0;
    if (!S.next(0, cur)) return;
    f32x4 acc[2][2][4][2];
#pragma unroll
    for (int a = 0; a < 2; ++a)
#pragma unroll
        for (int b = 0; b < 2; ++b)
#pragma unroll
            for (int m = 0; m < 4; ++m)
#pragma unroll
                for (int n = 0; n < 2; ++n) acc[a][b][m][n] = (f32x4){0.f, 0.f, 0.f, 0.f};
    bf16x8 At[4][2], B0[2][2], B1[2][2];
    const char* cA = (const char*)g.A + (size_t)cur.pm * tstep; const char* cB = (const char*)g.Bt + (size_t)cur.pn * tstep;
    S.a_ready(cur);
    if constexpr (SP2) {
        PG8_STAGE(PG8_SB(0, 0), cB, voffB); PG8_STAGE(PG8_SB(0, 1), cB + hstep, voffB); PG8_STAGE(PG8_SA(0, 0), cA, voffA); PG8_STAGE(PG8_SA(0, 1), cA + hstep, voffA);
        if (wr == 1) PG8_BAR;
        PG8_WAIT_V(2); PG8_BAR;
        PG8_STAGE(PG8_SB(1, 0), cB + kstep, voffB); PG8_STAGE(PG8_SA(1, 0), cA + kstep, voffA); PG8_STAGE(PG8_SB(1, 1), cB + hstep + kstep, voffB);
        PG8_WAIT_V(6); PG8_BAR;
    } else {
        PG8_STAGE(PG8_SB(0, 0), cB, voffB); PG8_STAGE(PG8_SA(0, 0), cA, voffA); PG8_STAGE(PG8_SB(0, 1), cB + hstep, voffB); PG8_STAGE(PG8_SA(0, 1), cA + hstep, voffA);
        if (wr == 1) PG8_BAR;
        PG8_WAIT_V(4); PG8_BAR;
        PG8_STAGE(PG8_SB(1, 0), cB + kstep, voffB); PG8_STAGE(PG8_SA(1, 0), cA + kstep, voffA); PG8_STAGE(PG8_SB(1, 1), cB + hstep + kstep, voffB);
        PG8_WAIT_V(6); PG8_BAR;
    }
    for (;;) {
        const bool has_next = S.next(ui + 1, nxt);
        const char* nA = has_next ? (const char*)g.A + (size_t)nxt.pm * tstep : cA; const char* nB = has_next ? (const char*)g.Bt + (size_t)nxt.pn * tstep : cB;
        for (int t = 0; t < nt; t += 2) {
            const bool last = (t == nt - 2);
            const char* a1 = cA + (size_t)(t + 1) * kstep;
            const char* a2 = last ? nA : cA + (size_t)(t + 2) * kstep; const char* b2 = last ? nB : cB + (size_t)(t + 2) * kstep;
            const char* a3 = a2 + kstep; const char* b3 = b2 + kstep;
            if (last && has_next) S.a_ready(nxt);
            if constexpr (SP2) {
            PG8_LDB(B0, 0, 0); PG8_LDB(B1, 0, 1); PG8_SCHED; PG8_LDA(At, 0, 0); PG8_STAGE(PG8_SA(1, 1), a1 + hstep, voffA);
            PG8_WAIT_V(8); PG8_WAIT_L(0); PG8_BAR; PG8_MMA(0, 0, At, B0); PG8_MMA(0, 1, At, B1); PG8_BAR; PG8_SCHED;
            PG8_LDA(At, 0, 1); PG8_STAGE(PG8_SB(0, 0), b2, voffB); PG8_STAGE(PG8_SB(0, 1), b2 + hstep, voffB); PG8_STAGE(PG8_SA(0, 0), a2, voffA);
            PG8_WAIT_V(8); PG8_WAIT_L(0); PG8_BAR; PG8_MMA(1, 0, At, B0); PG8_MMA(1, 1, At, B1); PG8_BAR; PG8_SCHED;
            PG8_LDB(B0, 1, 0); PG8_LDB(B1, 1, 1); PG8_SCHED; PG8_LDA(At, 1, 0); PG8_STAGE(PG8_SA(0, 1), a2 + hstep, voffA);
            PG8_WAIT_V(8); PG8_WAIT_L(0); PG8_BAR; PG8_MMA(0, 0, At, B0); PG8_MMA(0, 1, At, B1); PG8_BAR; PG8_SCHED;
            PG8_LDA(At, 1, 1); PG8_STAGE(PG8_SB(1, 0), b3, voffB); PG8_STAGE(PG8_SB(1, 1), b3 + hstep, voffB); PG8_STAGE(PG8_SA(1, 0), a3, voffA);
            PG8_WAIT_V(8); PG8_WAIT_L(0); PG8_BAR; PG8_MMA(1, 0, At, B0); PG8_MMA(1, 1, At, B1); PG8_BAR; PG8_SCHED;
            } else {
            PG8_LDB(B0, 0, 0); PG8_SCHED; PG8_LDA(At, 0, 0); PG8_STAGE(PG8_SA(1, 1), a1 + hstep, voffA);
            PG8_WAIT_L(8); PG8_BAR; PG8_WAIT_L(0); PG8_MMA(0, 0, At, B0); PG8_BAR; PG8_SCHED;
            PG8_LDB(B1, 0, 1); PG8_STAGE(PG8_SB(0, 0), b2, voffB);
            PG8_BAR; PG8_WAIT_L(0); PG8_MMA(0, 1, At, B1); PG8_BAR;
            PG8_LDA(At, 0, 1); PG8_STAGE(PG8_SA(0, 0), a2, voffA);
            PG8_BAR; PG8_WAIT_L(0); PG8_MMA(1, 0, At, B0); PG8_BAR; PG8_SCHED;
            PG8_STAGE(PG8_SB(0, 1), b2 + hstep, voffB);
            PG8_WAIT_V(6); PG8_BAR; PG8_MMA(1, 1, At, B1); PG8_BAR;
            PG8_LDB(B0, 1, 0); PG8_SCHED; PG8_LDA(At, 1, 0); PG8_STAGE(PG8_SA(0, 1), a2 + hstep, voffA);
            PG8_WAIT_L(8); PG8_BAR; PG8_WAIT_L(0); PG8_MMA(0, 0, At, B0); PG8_BAR; PG8_SCHED;
            PG8_LDB(B1, 1, 1); PG8_STAGE(PG8_SB(1, 0), b3, voffB);
            PG8_BAR; PG8_WAIT_L(0); PG8_MMA(0, 1, At, B1); PG8_BAR;
            PG8_LDA(At, 1, 1); PG8_STAGE(PG8_SA(1, 0), a3, voffA);
            PG8_BAR; PG8_WAIT_L(0); PG8_MMA(1, 0, At, B0); PG8_BAR; PG8_SCHED;
            PG8_STAGE(PG8_SB(1, 1), b3 + hstep, voffB);
            PG8_WAIT_V(6); PG8_BAR; PG8_MMA(1, 1, At, B1); PG8_BAR;
            }
        }
        if constexpr (ALIGN_EPI) { if (wr == 0) PG8_BAR; }
        if constexpr (!Epi::AFTER_DRAIN) { E(acc, cur, wr, wc, fr, fq); S.done(cur); }
        if (!has_next) break;
#pragma unroll
        for (int a = 0; a < 2; ++a)
#pragma unroll
            for (int b = 0; b < 2; ++b)
#pragma unroll
                for (int m = 0; m < 4; ++m)
#pragma unroll
                    for (int n = 0; n < 2; ++n) acc[a][b][m][n] = (f32x4){0.f, 0.f, 0.f, 0.f};
        cur = nxt; cA = nA; cB = nB; ++ui;
        if constexpr (ALIGN_EPI) { if (wr == 1) PG8_BAR; }
    }
    PG8_WAIT_V(0);
    if constexpr (!ALIGN_EPI) { if (wr == 0) PG8_BAR; }
    PG8_BAR;
    if constexpr (Epi::AFTER_DRAIN) { E.fused(acc, cur, wr, wc, fr, fq, lds, wid, lane); S.done(cur); }
#undef PG8_SA
#undef PG8_SB
#undef PG8_STAGE
#undef PG8_LDA
#undef PG8_LDB
#undef PG8_MMA
#undef PG8_WAIT_V
#undef PG8_WAIT_L
#undef PG8_BAR
#undef PG8_SCHED
}
}

#define LAS __attribute__((address_space(3)))
typedef unsigned short bf16;
using bf16x8 = __attribute__((ext_vector_type(8))) short;
using s16x4  = __attribute__((ext_vector_type(4))) short;
using f32x16 = __attribute__((ext_vector_type(16))) float;
using f32x4  = __attribute__((ext_vector_type(4))) float;
using u32x4  = __attribute__((ext_vector_type(4))) unsigned;
using u32x2v = __attribute__((ext_vector_type(2))) unsigned;

constexpr int NB = 4, S = 4096, DM = 2048, M = NB * S, HD = 128, DFF = 5632;
constexpr int NPH = 14;
#ifndef PH_MASK
#define PH_MASK 127
#endif
constexpr int LDS_BYTES = 147456;
constexpr int NTHR = 512;

constexpr size_t MiB = 1u << 20;
constexpr size_t WS_CTL = 0, CTL_BYTES = 1 * MiB;
constexpr size_t CTL_SS1 = 131072, CTL_SS2 = 2 * 131072, CTL_SS3 = 3 * 131072, CTL_SS4 = 4 * 131072;
constexpr size_t WS_SS0 = 1 * MiB, WS_SSMEM = WS_SS0 + 65536, WS_BIAS = WS_SSMEM + 4096;
constexpr size_t WS_COS = 2 * MiB, WS_SIN = 3 * MiB;
constexpr size_t WS_WINA = 4 * MiB;
constexpr size_t WS_WOA = WS_WINA + (size_t)3840 * 2048 * 2;
constexpr size_t WS_WGUA = WS_WOA + (size_t)2048 * 2048 * 2;
constexpr size_t WS_WDA = WS_WGUA + (size_t)11264 * 2048 * 2;
constexpr size_t WS_WINB = WS_WDA + (size_t)2048 * 5632 * 2;
constexpr size_t WS_WOB = WS_WINB + (size_t)3072 * 2048 * 2;
constexpr size_t WS_WGUB = WS_WOB + (size_t)2048 * 1024 * 2;
constexpr size_t WS_WDB = WS_WGUB + (size_t)11264 * 2048 * 2;
constexpr size_t WS_WMEMA = WS_WDB + (size_t)2048 * 5632 * 2;
constexpr size_t WS_WMEMB = WS_WMEMA + (size_t)1024 * 2048 * 2;
constexpr size_t WS_W1K = WS_WMEMB + (size_t)1024 * 2048 * 2;
constexpr size_t WS_W1V = WS_W1K + (size_t)256 * 4096 * 2;
constexpr size_t WS_W2K = WS_W1V + (size_t)256 * 4096 * 2;
constexpr size_t WS_W2V = WS_W2K + (size_t)128 * 256 * 2;
constexpr size_t WS_HB = WS_W2V + (size_t)128 * 256 * 2;
constexpr size_t WS_MEMB = WS_HB + (size_t)M * DM * 2;
constexpr size_t WS_MKVA = WS_MEMB + (size_t)1024 * 2048 * 2;
constexpr size_t WS_MKVB = WS_MKVA + (size_t)1024 * 1024 * 2;
constexpr size_t WS_KC = WS_MKVB + (size_t)1024 * 1024 * 2;
constexpr size_t WS_VC = WS_KC + (size_t)NB * 256 * 2 * 128 * 2;
constexpr size_t WS_SEL = WS_VC + (size_t)NB * 256 * 2 * 128 * 2;
constexpr size_t WS_GATES = WS_SEL + (size_t)NB * 2 * S * 8;
constexpr size_t WS_OSCR = WS_GATES + (size_t)M * 36 * 4;
constexpr size_t WS_OVL = WS_OSCR + (size_t)256 * 131072;
constexpr size_t OVL_BYTES = (size_t)M * DFF * 2;
constexpr size_t WS_END = WS_OVL + OVL_BYTES;
constexpr size_t OA_Q = 0, OA_KV = (size_t)M * 1536 * 2, OA_ZM = 2 * (size_t)M * 1536 * 2, OA_O = OA_ZM + (size_t)M * 512 * 2;
constexpr size_t OB_Q = 0, OB_ZM = (size_t)M * 1536 * 2, OB_KS = OB_ZM + (size_t)M * 512 * 2, OB_VS = OB_KS + (size_t)M * 512 * 2, OB_O = OB_VS + (size_t)M * 512 * 2;
static_assert(OA_O + (size_t)M * 2048 * 2 <= OVL_BYTES && OB_O + (size_t)M * 1024 * 2 <= OVL_BYTES, "overlay");
static_assert(WS_END <= (size_t)512 * MiB, "workspace map must fit 4x the largest tensor");

struct Params { const float* in[30]; float* out; unsigned char* ws; int ph_lo, ph_hi; };

__device__ __forceinline__ float wave_sum(float v) {
#pragma unroll
    for (int o = 1; o < 64; o <<= 1) v += __shfl_xor(v, o);
    return v;
}
typedef float f32x2_t __attribute__((ext_vector_type(2))); typedef __bf16 bf16x2_t __attribute__((ext_vector_type(2)));
__device__ __forceinline__ unsigned cvtpk(float lo, float hi) { f32x2_t v = {lo, hi}; bf16x2_t b = __builtin_convertvector(v, bf16x2_t); return __builtin_bit_cast(unsigned, b); }
__device__ __forceinline__ f32x16 zero16() { f32x16 z = {}; asm volatile("" : "+v"(z)); return z; }
__device__ __forceinline__ float bf2f(unsigned short b) { return __uint_as_float(((unsigned)b) << 16); }
__device__ __forceinline__ int unperm(int p) { return 4 * (p >> 3) + (p & 3) + 64 * ((p >> 2) & 1); }

__device__ __forceinline__ int rperm(int d) { return 8 * ((d & 63) >> 2) + 4 * (d >> 6) + (d & 3); }
struct SrcMat { const float* W; const float* gain; bf16* WT; int ld, ncols, K, kind; };
__device__ __forceinline__ int dst_of(int kind, int c) {
    switch (kind) {
    case 0:
        if (c < 1536) return (c & ~127) + rperm(c & 127);
        if (c < 3072) { const int j = c - 1536, br = j >> 8; return 1536 + (j & ~127) + ((br & 1) ? (j & 127) : rperm(j & 127)); }
        if (c < 3108) return 3584 + (c - 3072);
        return 3072 + (c - 3108);
    case 1: return (c >> 7) * 256 + (c & 127);
    case 2: return (c >> 7) * 256 + 128 + (c & 127);
    case 3: return c < 1536 ? (c & ~127) + rperm(c & 127) : c;
    case 4: return c < 512 ? 2048 + (c & ~127) + rperm(c & 127) : 2048 + c;
    default: return c;
    }
}
__device__ __forceinline__ void tr_item(const SrcMat& sm, LAS float* scr, int item, int lane) {
    const int ncb = (sm.ncols + 63) >> 6, kb = item / ncb, cb = item % ncb, k0 = 64 * kb, c0 = 64 * cb;
    const int lr = lane >> 4, lc = (lane & 15) * 4;
    const bool cv = (c0 + lc) < sm.ncols;
    f32x4 v[16]; float zf = 0.f; asm volatile("" : "+v"(zf));
#pragma unroll
    for (int i = 0; i < 16; ++i) { v[i] = (f32x4){zf, zf, zf, zf}; if (cv) v[i] = *(const f32x4*)(sm.W + (size_t)(k0 + 4 * i + lr) * sm.ld + c0 + lc); }
    if (sm.gain) {
#pragma unroll
        for (int i = 0; i < 16; ++i) v[i] = v[i] * sm.gain[k0 + 4 * i + lr];
    }
#pragma unroll
    for (int i = 0; i < 16; ++i) { LAS float* s = scr + (4 * i + lr) * 65 + lc; s[0] = v[i].x; s[1] = v[i].y; s[2] = v[i].z; s[3] = v[i].w; }
    asm volatile("s_waitcnt lgkmcnt(0)" ::: "memory");
    const int c8 = lane & 7;
#pragma unroll
    for (int j = 0; j < 8; ++j) { const int n = (lane >> 3) + 8 * j; const LAS float* s = scr + (8 * c8) * 65 + n;
        u32x4 o; o.x = cvtpk(s[0 * 65], s[1 * 65]); o.y = cvtpk(s[2 * 65], s[3 * 65]); o.z = cvtpk(s[4 * 65], s[5 * 65]); o.w = cvtpk(s[6 * 65], s[7 * 65]);
        if (c0 + n < sm.ncols) *(u32x4*)(sm.WT + (size_t)dst_of(sm.kind, c0 + n) * sm.K + k0 + 8 * c8) = o; }
    asm volatile("s_waitcnt lgkmcnt(0)" ::: "memory");
}
__device__ __forceinline__ void row_to_bf16_ss(const float* xrow, bf16* orow, float* ssp, int lane) {
    const f32x4* xr = (const f32x4*)xrow + lane; float s = 0.f;
    u32x2v* o8 = (u32x2v*)orow + lane;
#pragma unroll
    for (int j = 0; j < 8; ++j) { const f32x4 v = xr[64 * j]; s += (v.x * v.x + v.y * v.y) + (v.z * v.z + v.w * v.w);
        u32x2v w; w.x = cvtpk(v.x, v.y); w.y = cvtpk(v.z, v.w); o8[64 * j] = w; }
    s = wave_sum(s);
    if (lane == 0) *ssp = s;
}
__device__ __forceinline__ void sincos_f(float a, float& sn, float& cs) {
    const float q = rintf(a * 0.636619772367581343f);
    float r = fmaf(-q, 1.5707962513e+00f, a); r = fmaf(-q, 7.5497894159e-08f, r); r = fmaf(-q, 5.3903029534e-15f, r);
    const float r2 = r * r;
    float sp = 2.7557319224e-6f; sp = fmaf(sp, r2, -1.9841269841e-4f); sp = fmaf(sp, r2, 8.3333333333e-3f); sp = fmaf(sp, r2, -1.6666666667e-1f); const float sr = fmaf(sp * r2, r, r);
    float cp = -2.7557319224e-7f; cp = fmaf(cp, r2, 2.4801587302e-5f); cp = fmaf(cp, r2, -1.3888888889e-3f); cp = fmaf(cp, r2, 4.1666666667e-2f); cp = fmaf(cp, r2, -0.5f); float one = 1.0f; asm volatile("" : "+v"(one)); const float cr = fmaf(cp, r2, one);
    const int n = ((int)q) & 3;
    sn = (n == 0) ? sr : (n == 1) ? cr : (n == 2) ? -sr : -cr;
    cs = (n == 0) ? cr : (n == 1) ? -sr : (n == 2) ? -cr : sr;
}
__device__ __forceinline__ void phase_prologue(const Params& p, unsigned char* lds_) {
    unsigned char* ws = p.ws;
    int tid = threadIdx.x; asm volatile("" : "+v"(tid));
    const int lane = tid & 63, wave = tid >> 6;
    LAS float* scr = (LAS float*)((LAS unsigned char*)lds_ + wave * 16384);
    const int gw = blockIdx.x * 8 + wave, NGW = gridDim.x * 8;
    LAS float* scr2 = (LAS float*)((LAS unsigned char*)lds_ + wave * 17408);
#define TR_SRC(src_, gain_, dstoff_, ld_, ncols_, K_, kind_) { const int ni = ((K_) / 64) * (((ncols_) + 63) / 64); if (r < ni) { \
        SrcMat sm; sm.W = (src_); sm.gain = (gain_); sm.WT = (bf16*)(ws + (dstoff_)); sm.ld = (ld_); sm.ncols = (ncols_); sm.K = (K_); sm.kind = (kind_); tr_item(sm, scr2, r, lane); continue; } r -= ni; }
    constexpr int NITEMS = 32 * 57 + 32 * 32 + 4 * 32 * 88 + 2 * 88 * 32 + 32 * 32 + 32 * 16 + 16 * 32 + 2 * 32 * 16 + 2 * 64 * 4 + 2 * 4 * 2;
    for (int it = gw; it < NITEMS; it += NGW) {
        int r = it;
        TR_SRC(p.in[15], p.in[14], WS_WGUA, DFF, DFF, 2048, 1)
        TR_SRC(p.in[16], p.in[14], WS_WGUA, DFF, DFF, 2048, 2)
        TR_SRC(p.in[26], p.in[25], WS_WGUB, DFF, DFF, 2048, 1)
        TR_SRC(p.in[27], p.in[25], WS_WGUB, DFF, DFF, 2048, 2)
        TR_SRC(p.in[17], nullptr, WS_WDA, 2048, 2048, 5632, 9)
        TR_SRC(p.in[28], nullptr, WS_WDB, 2048, 2048, 5632, 9)
        TR_SRC(p.in[3], p.in[2], WS_WINA, 3620, 3620, 2048, 0)
        TR_SRC(p.in[21], p.in[20], WS_WINB, 2048, 2048, 2048, 3)
        TR_SRC(p.in[19], p.in[18], WS_WINB, 1024, 1024, 2048, 4)
        TR_SRC(p.in[13], nullptr, WS_WOA, 2048, 2048, 2048, 9)
        TR_SRC(p.in[24], nullptr, WS_WOB, 2048, 2048, 1024, 9)
        TR_SRC(p.in[12], p.in[11], WS_WMEMA, 1024, 1024, 2048, 9)
        TR_SRC(p.in[23], p.in[22], WS_WMEMB, 1024, 1024, 2048, 9)
        TR_SRC(p.in[6], nullptr, WS_W1K, 256, 256, 4096, 9)
        TR_SRC(p.in[9], nullptr, WS_W1V, 256, 256, 4096, 9)
        TR_SRC(p.in[7], nullptr, WS_W2K, 128, 128, 256, 9)
        TR_SRC(p.in[10], nullptr, WS_W2V, 128, 128, 256, 9)
    }
#undef TR_SRC
    { u32x4* z = (u32x4*)(ws + WS_WINA + (size_t)3620 * 2048 * 2); unsigned zu = 0u; asm volatile("" : "+v"(zu)); const u32x4 zz = {zu, zu, zu, zu};
      for (int e = blockIdx.x * NTHR + tid; e < 220 * 2048 * 2 / 16; e += gridDim.x * NTHR) z[e] = zz; }
    for (int m = gw; m < M + 1024; m += NGW) {
        if (m < M) row_to_bf16_ss(p.in[0] + (size_t)m * DM, (bf16*)(ws + WS_HB) + (size_t)m * DM, (float*)(ws + WS_SS0) + m, lane);
        else { const int mm = m - M; row_to_bf16_ss(p.in[1] + (size_t)mm * DM, (bf16*)(ws + WS_MEMB) + (size_t)mm * DM, (float*)(ws + WS_SSMEM) + mm, lane); }
    }
    for (int e = blockIdx.x * NTHR + tid; e < S * 64; e += gridDim.x * NTHR) {
        const int t = e >> 6, f = e & 63;
        const float ff = (float)f, chi = 2.0762050152e-01f, clo = 4.4122106246e-09f;
        const float yh = ff * chi, ye = fmaf(ff, chi, -yh) + ff * clo;
        const float inv = __builtin_amdgcn_exp2f(-yh) * (1.0f - ye * 0.69314718056f);
        const float ang = (float)t * inv;
        float sn, cs; sincos_f(ang, sn, cs);
        ((float*)(ws + WS_COS))[e] = cs; ((float*)(ws + WS_SIN))[e] = sn;
    }
    for (int o = gw; o < 512; o += NGW) {
        const int kv = o >> 8, n = o & 255; const float* pe = p.in[kv ? 8 : 5]; const float* w1 = p.in[kv ? 9 : 6];
        float s = 0.f; for (int k = lane; k < 4096; k += 64) s += pe[k] * w1[(size_t)k * 256 + n];
        s = wave_sum(s); if (lane == 0) ((float*)(ws + WS_BIAS))[o] = s;
    }
}

constexpr int SHM_K = 16384, SHM_V = 16384;
constexpr int ATT_WS_OFF = 65536;
constexpr int ATT_UNIT_OFF = 65536 + 2048;
#define KSWZ(row, colB) ((row) * 256 + ((colB) ^ (((row) & 7) << 4)))
#define SBAR() __builtin_amdgcn_sched_barrier(0)
__device__ __forceinline__ int crow(int r, int hi) { return (r & 3) + 8 * (r >> 2) + 4 * hi; }
__device__ __forceinline__ void qkt(f32x16& p0, f32x16& p1, const char* Ks, const bf16x8 (&qr)[8], int r32, int hi) {
    p0 = zero16(); p1 = zero16();
    __builtin_amdgcn_s_setprio(1);
#pragma unroll
    for (int d0 = 0; d0 < 8; ++d0) { const int cb = (d0 * 16 + hi * 8) * 2;
        const bf16x8 b0 = *reinterpret_cast<const bf16x8*>(Ks + KSWZ(r32, cb));
        const bf16x8 b1 = *reinterpret_cast<const bf16x8*>(Ks + KSWZ(32 + r32, cb));
        p0 = __builtin_amdgcn_mfma_f32_32x32x16_bf16(b0, qr[d0], p0, 0, 0, 0);
        p1 = __builtin_amdgcn_mfma_f32_32x32x16_bf16(b1, qr[d0], p1, 0, 0, 0); }
    __builtin_amdgcn_s_setprio(0);
}
__device__ __forceinline__ void qkt_g(f32x16& p0, f32x16& p1, const char* Ks, const bf16* qp, int r32, int hi) {
    p0 = zero16(); p1 = zero16();
#pragma unroll
    for (int d0 = 0; d0 < 8; ++d0) { const int cb = (d0 * 16 + hi * 8) * 2;
        const bf16x8 q = *(const bf16x8*)(qp + d0 * 16);
        const bf16x8 b0 = *reinterpret_cast<const bf16x8*>(Ks + KSWZ(r32, cb));
        const bf16x8 b1 = *reinterpret_cast<const bf16x8*>(Ks + KSWZ(32 + r32, cb));
        p0 = __builtin_amdgcn_mfma_f32_32x32x16_bf16(b0, q, p0, 0, 0, 0);
        p1 = __builtin_amdgcn_mfma_f32_32x32x16_bf16(b1, q, p1, 0, 0, 0); }
}
__device__ __forceinline__ int v_st(int k, int c) { const int kk = (k & ~0xC) | ((k & 4) << 1) | ((k & 8) >> 1); return ((kk >> 3) * 4 + (c >> 5)) * 512 + ((kk & 7) * 32 + (c & 31)) * 2; }
__device__ __forceinline__ int v_rd_base(int lane) { return ((lane & 3) << 3) | (((lane >> 2) & 3) << 6) | (((lane >> 4) & 1) << 5) | (((lane >> 5) & 1) << 8); }
constexpr int v_rd_off(int d0, int ks, int half) { return d0 * 512 + ks * 4096 + half * 2048; }
template <int OFF> __device__ __forceinline__ s16x4 tr_read(int vb) {
    s16x4 r; asm volatile("ds_read_b64_tr_b16 %0, %1 offset:%2" : "=&v"(r) : "v"(vb), "i"(OFF) : "memory"); return r;
}
template <int D0> __device__ __forceinline__ void pv_one(f32x16& od, int vb, bf16x8 pa0, bf16x8 pa1, bf16x8 pa2, bf16x8 pa3) {
    const s16x4 l0 = tr_read<v_rd_off(D0, 0, 0)>(vb), h0 = tr_read<v_rd_off(D0, 0, 1)>(vb), l1 = tr_read<v_rd_off(D0, 1, 0)>(vb), h1 = tr_read<v_rd_off(D0, 1, 1)>(vb);
    const s16x4 l2 = tr_read<v_rd_off(D0, 2, 0)>(vb), h2 = tr_read<v_rd_off(D0, 2, 1)>(vb), l3 = tr_read<v_rd_off(D0, 3, 0)>(vb), h3 = tr_read<v_rd_off(D0, 3, 1)>(vb);
    asm volatile("s_waitcnt lgkmcnt(0)" ::: "memory"); SBAR();
#define PK(L, H) (bf16x8){L[0], L[1], L[2], L[3], H[0], H[1], H[2], H[3]}
    od = __builtin_amdgcn_mfma_f32_32x32x16_bf16(pa0, PK(l0, h0), od, 0, 0, 0);
    od = __builtin_amdgcn_mfma_f32_32x32x16_bf16(pa1, PK(l1, h1), od, 0, 0, 0);
    od = __builtin_amdgcn_mfma_f32_32x32x16_bf16(pa2, PK(l2, h2), od, 0, 0, 0);
    od = __builtin_amdgcn_mfma_f32_32x32x16_bf16(pa3, PK(l3, h3), od, 0, 0, 0);
#undef PK
}
__device__ __forceinline__ void pv_d0(f32x16 (&o)[4], int vb, bf16x8 pa0, bf16x8 pa1, bf16x8 pa2, bf16x8 pa3) {
    __builtin_amdgcn_s_setprio(1);
    pv_one<0>(o[0], vb, pa0, pa1, pa2, pa3); pv_one<1>(o[1], vb, pa0, pa1, pa2, pa3); pv_one<2>(o[2], vb, pa0, pa1, pa2, pa3); pv_one<3>(o[3], vb, pa0, pa1, pa2, pa3);
    __builtin_amdgcn_s_setprio(0);
}
__device__ __forceinline__ void p_to_frags(const f32x16& p0, const f32x16& p1, bf16x8& pa0, bf16x8& pa1, bf16x8& pa2, bf16x8& pa3) {
#define PK4(P, BASE, OUT) do { unsigned a0 = cvtpk(P[BASE + 0], P[BASE + 1]), a1 = cvtpk(P[BASE + 2], P[BASE + 3]);   \
    unsigned b0 = cvtpk(P[BASE + 4], P[BASE + 5]), b1 = cvtpk(P[BASE + 6], P[BASE + 7]);                              \
    auto r0 = __builtin_amdgcn_permlane32_swap(a0, b0, false, false); auto r1 = __builtin_amdgcn_permlane32_swap(a1, b1, false, false); \
    u32x4 w = {r0[0], r1[0], r0[1], r1[1]}; OUT = *reinterpret_cast<bf16x8*>(&w); } while (0)
    PK4(p0, 0, pa0); PK4(p0, 8, pa1); PK4(p1, 0, pa2); PK4(p1, 8, pa3);
#undef PK4
}
__device__ __forceinline__ float pair_max(float v) { auto rr = __builtin_amdgcn_permlane32_swap(__float_as_uint(v), __float_as_uint(v), false, false); return fmaxf(__uint_as_float(rr[0]), __uint_as_float(rr[1])); }
__device__ __forceinline__ float pair_sum(float v) { auto rr = __builtin_amdgcn_permlane32_swap(__float_as_uint(v), __float_as_uint(v), false, false); return __uint_as_float(rr[0]) + __uint_as_float(rr[1]); }

struct MaskNone {
    __device__ __forceinline__ bool active(int) const { return true; }
    __device__ __forceinline__ bool lane_off(int) const { return false; }
    __device__ __forceinline__ void apply(int, f32x16&, f32x16&, int) const {}
};
struct MaskBand {
    int q, W, qmin, qmax;
    __device__ __forceinline__ bool active(int kt) const { const int k0 = kt * 64; return (k0 <= qmax) && (k0 + 63 >= qmin - (W - 1)); }
    __device__ __forceinline__ bool lane_off(int) const { return false; }
    __device__ __forceinline__ void apply(int kt, f32x16& p0, f32x16& p1, int hi) const {
        const int k0 = kt * 64;
        if (k0 + 63 <= qmin && k0 >= qmax - (W - 1)) return;
#pragma unroll
        for (int r = 0; r < 16; ++r) { const int d = q - (k0 + crow(r, hi));
            p0[r] = ((unsigned)d < (unsigned)W) ? p0[r] : -INFINITY;
            p1[r] = ((unsigned)(d - 32) < (unsigned)W) ? p1[r] : -INFINITY; }
    }
};
struct MaskSel {
    int q, qmin, qmax; unsigned long long sel;
    __device__ __forceinline__ bool active(int kt) const { return (kt * 64 <= qmax) && __any((int)((sel >> kt) & 1ull)); }
    __device__ __forceinline__ bool lane_off(int kt) const { return ((sel >> kt) & 1ull) == 0ull; }
    __device__ __forceinline__ void apply(int kt, f32x16& p0, f32x16& p1, int hi) const {
        const int k0 = kt * 64;
        if (k0 + 63 <= qmin) return;
#pragma unroll
        for (int r = 0; r < 16; ++r) { const int d = q - (k0 + crow(r, hi));
            p0[r] = (d >= 0) ? p0[r] : -INFINITY;
            p1[r] = (d >= 32) ? p1[r] : -INFINITY; }
    }
};

__device__ __forceinline__ void imp_mma(f32x16& oi, bf16x8 pa, int kt, int ks, int cb, int r32, int hi) {
    int rl = r32; asm volatile("" : "+v"(rl));
    const int d0 = (64 * kt + 16 * ks + 8 * hi) - 4 * (32 * cb + rl);
    u32x4 w;
#pragma unroll
    for (int e2 = 0; e2 < 4; ++e2) {
        const int da = d0 + 2 * e2, db = da + 1;
        const unsigned lo = ((unsigned)(da + 1) <= 4u) ? 0x3F80u : 0u, hh = ((unsigned)(db + 1) <= 4u) ? 0x3F80u : 0u;
        w[e2] = lo | (hh << 16);
    }
    oi = __builtin_amdgcn_mfma_f32_32x32x16_bf16(pa, *reinterpret_cast<bf16x8*>(&w), oi, 0, 0, 0);
}

template <int MODE, bool QREG, class MaskF>
__device__ __forceinline__ void attn_stream(char* lds, const bf16x8 (&qr)[8], const bf16* qp, const bf16* Kb, const bf16* Vb, long ldk, int kt0, int kt1, const MaskF& mf,
                                            f32x16 (&o)[4], float& m_reg, float& l_reg, float inv_l, f32x16& oi0, f32x16& oi1) {
    int tid = threadIdx.x; asm volatile("" : "+v"(tid));
    const int wid = __builtin_amdgcn_readfirstlane(tid >> 6), lane = tid & 63, r32 = lane & 31, hi = lane >> 5;
    char* V_lds = lds; char* K_lds = lds + 2 * SHM_V;
    float* al_l = (float*)(lds + ATT_WS_OFF) + wid * 64;
    const int sr = tid >> 4, sc = (tid & 15) * 8, vst0 = v_st(sr, sc), vst1 = v_st(32 + sr, sc);
    const int vb0 = (int)(uintptr_t)V_lds + v_rd_base(lane);
    bf16x8 vs0 = {}, vs1 = {}, ks0, ks1;
    if (kt1 < kt0) return;
#define SLOAD(kt_) do { const long r0_ = (long)((kt_) * 64 + sr) * ldk + sc, r1_ = r0_ + 32 * ldk; ks0 = *(const bf16x8*)(Kb + r0_); ks1 = *(const bf16x8*)(Kb + r1_); \
    if (MODE == 0 || MODE == 2) { vs0 = *(const bf16x8*)(Vb + r0_); vs1 = *(const bf16x8*)(Vb + r1_); } } while (0)
#define SWRITE(b_) do { *(bf16x8*)(K_lds + (b_) * SHM_K + KSWZ(sr, sc * 2)) = ks0; *(bf16x8*)(K_lds + (b_) * SHM_K + KSWZ(32 + sr, sc * 2)) = ks1; \
    if (MODE == 0 || MODE == 2) { *(bf16x8*)(V_lds + (b_) * SHM_V + vst0) = vs0; *(bf16x8*)(V_lds + (b_) * SHM_V + vst1) = vs1; } } while (0)
    SLOAD(kt0); SWRITE(0); __syncthreads();
    for (int kt = kt0; kt <= kt1; ++kt) {
        const int buf = (kt - kt0) & 1;
        if (kt < kt1) SLOAD(kt + 1);
        if (mf.active(kt)) {
            f32x16 p0, p1;
            if (QREG) qkt(p0, p1, K_lds + buf * SHM_K, qr, r32, hi); else qkt_g(p0, p1, K_lds + buf * SHM_K, qp, r32, hi);
            mf.apply(kt, p0, p1, hi);
            if (MODE >= 2) {
                const float mfix = m_reg - __builtin_amdgcn_logf(inv_l);
#pragma unroll
                for (int r = 0; r < 16; r += 2) { const f32x2_t a = (f32x2_t){p0[r], p0[r + 1]} - mfix, bq = (f32x2_t){p1[r], p1[r + 1]} - mfix;
                    p0[r] = __builtin_amdgcn_exp2f(a.x); p0[r + 1] = __builtin_amdgcn_exp2f(a.y); p1[r] = __builtin_amdgcn_exp2f(bq.x); p1[r + 1] = __builtin_amdgcn_exp2f(bq.y); }
                bf16x8 pa0, pa1, pa2, pa3; p_to_frags(p0, p1, pa0, pa1, pa2, pa3);
                if (MODE == 2) pv_d0(o, vb0 + buf * SHM_V, pa0, pa1, pa2, pa3);
                else if (kt < 2) { imp_mma(oi0, pa0, kt, 0, 0, r32, hi); imp_mma(oi0, pa1, kt, 1, 0, r32, hi); imp_mma(oi0, pa2, kt, 2, 0, r32, hi); imp_mma(oi0, pa3, kt, 3, 0, r32, hi);
                              if (kt == 1) imp_mma(oi1, pa3, kt, 3, 1, r32, hi); }
                else { imp_mma(oi1, pa0, kt, 0, 1, r32, hi); imp_mma(oi1, pa1, kt, 1, 1, r32, hi); imp_mma(oi1, pa2, kt, 2, 1, r32, hi); imp_mma(oi1, pa3, kt, 3, 1, r32, hi); }
            } else {
                float pmax = p0[0];
#pragma unroll
                for (int r = 1; r < 16; ++r) pmax = fmaxf(pmax, p0[r]);
#pragma unroll
                for (int r = 0; r < 16; ++r) pmax = fmaxf(pmax, p1[r]);
                const bool off = mf.lane_off(kt);
                pmax = off ? -INFINITY : pmax;
                pmax = pair_max(pmax);
                float mn = m_reg, alpha = 1.f;
                if (!__all(pmax - m_reg <= 8.0f)) {
                    mn = fmaxf(m_reg, pmax); alpha = __builtin_amdgcn_exp2f(m_reg - mn); m_reg = mn; }
                const float mne = off ? INFINITY : mn;
                f32x2_t ps2 = {0.f, 0.f};
#pragma unroll
                for (int r = 0; r < 16; r += 2) { const f32x2_t a = (f32x2_t){p0[r], p0[r + 1]} - mne, bq = (f32x2_t){p1[r], p1[r + 1]} - mne;
                    p0[r] = __builtin_amdgcn_exp2f(a.x); p0[r + 1] = __builtin_amdgcn_exp2f(a.y); p1[r] = __builtin_amdgcn_exp2f(bq.x); p1[r + 1] = __builtin_amdgcn_exp2f(bq.y);
                    ps2 += (f32x2_t){p0[r], p0[r + 1]} + (f32x2_t){p1[r], p1[r + 1]}; }
                float ps = pair_sum(ps2.x + ps2.y);
                l_reg = l_reg * alpha + ps;
                if (MODE == 0) {
                    if (__any(alpha < 1.f)) {
                        if (hi == 0) al_l[r32] = alpha;
                        asm volatile("s_waitcnt lgkmcnt(0)" ::: "memory");
#pragma unroll
                        for (int r = 0; r < 16; ++r) { const float a = al_l[crow(r, hi)];
#pragma unroll
                            for (int d = 0; d < 4; ++d) o[d][r] *= a; }
                    }
                    bf16x8 pa0, pa1, pa2, pa3; p_to_frags(p0, p1, pa0, pa1, pa2, pa3);
                    pv_d0(o, vb0 + buf * SHM_V, pa0, pa1, pa2, pa3);
                }
            }
        }
        if (kt < kt1) SWRITE(buf ^ 1);
        __syncthreads();
    }
#undef SLOAD
#undef SWRITE
}
__device__ __forceinline__ void load_q(bf16x8 (&qr)[8], const bf16* qp) {
#pragma unroll
    for (int d0 = 0; d0 < 8; ++d0) qr[d0] = *(const bf16x8*)(qp + d0 * 16);
}
__device__ __forceinline__ void row_fac(float* al_l, float fac, int r32, int hi, float (&f)[16]) {
    asm volatile("s_waitcnt lgkmcnt(0)" ::: "memory");
    if (hi == 0) al_l[r32] = fac;
    asm volatile("s_waitcnt lgkmcnt(0)" ::: "memory");
#pragma unroll
    for (int r = 0; r < 16; ++r) f[r] = al_l[crow(r, hi)];
    asm volatile("s_waitcnt lgkmcnt(0)" ::: "memory");
}
__device__ __forceinline__ int next_unit(char* lds, unsigned* ctr) {
    volatile int* uw = (volatile int*)(lds + ATT_UNIT_OFF);
    asm volatile("s_waitcnt lgkmcnt(0)\n\ts_barrier" ::: "memory");
    if (threadIdx.x == 0) *uw = (int)atomicAdd(ctr, 1u);
    asm volatile("s_waitcnt lgkmcnt(0)\n\ts_barrier" ::: "memory");
    return __builtin_amdgcn_readfirstlane(*uw);
}

__device__ __forceinline__ void mem_attn_unit(char* lds, int unit, const bf16* ZM, const bf16* MKV, bf16* O, int ldo, int ocol0) {
    int tid = threadIdx.x; asm volatile("" : "+v"(tid));
    const int wid = __builtin_amdgcn_readfirstlane(tid >> 6), lane = tid & 63, r32 = lane & 31, hi = lane >> 5;
    const int b = unit >> 6, h = (unit >> 4) & 3, qb = unit & 15;
    const int t = qb * 256 + wid * 32 + r32;
    bf16x8 qr[8]; load_q(qr, ZM + ((size_t)(b * S + t)) * 512 + h * 128 + hi * 8);
    f32x16 o[4] = {zero16(), zero16(), zero16(), zero16()}; float m_reg = -1e30f, l_reg = 0.f; f32x16 d0_, d1_;
    const bf16* Kb = MKV + (size_t)(b * 256) * 1024 + h * 128;
    MaskNone mk;
    attn_stream<0, true>(lds, qr, nullptr, Kb, Kb + 512, 1024, 0, 3, mk, o, m_reg, l_reg, 0.f, d0_, d1_);
    float f[16]; row_fac((float*)(lds + ATT_WS_OFF) + wid * 64, l_reg > 0.f ? 1.0f / l_reg : 0.f, r32, hi, f);
    bf16* Ow = O + ((size_t)(b * S + qb * 256 + wid * 32)) * ldo + ocol0 + h * 128;
#pragma unroll
    for (int r = 0; r < 16; ++r) { const int orow = crow(r, hi);
#pragma unroll
        for (int d = 0; d < 4; ++d) Ow[(size_t)orow * ldo + d * 32 + r32] = (bf16)(cvtpk(o[d][r] * f[r], 0.f) & 0xffffu); }
}

__device__ __forceinline__ void nsa_cmp_unit(char* lds, int unit, unsigned char* ws, float* cmp_part) {
    int tid = threadIdx.x; asm volatile("" : "+v"(tid));
    const int wid = __builtin_amdgcn_readfirstlane(tid >> 6), lane = tid & 63, r32 = lane & 31, hi = lane >> 5;
    const int qb = 31 - (unit >> 3), b = (unit >> 1) & 3, g = unit & 1;
    const int slab = wid & 3, ht = wid >> 2;
    const int t = qb * 128 + slab * 32 + r32;
    const bf16* Q = (const bf16*)(ws + WS_OVL + OA_Q); bf16* O = (bf16*)cmp_part;
    const float* gates = (const float*)(ws + WS_GATES);
    const bf16* Kb = (const bf16*)(ws + WS_KC) + (size_t)(b * 256 * 2 + g) * 128;
    const bf16* Vb = (const bf16*)(ws + WS_VC) + (size_t)(b * 256 * 2 + g) * 128;
    float* al_l = (float*)(lds + ATT_WS_OFF) + wid * 64;
    MaskBand mk; mk.q = (t - 31) >> 4; mk.W = 1 << 30; mk.qmin = __builtin_amdgcn_readlane(mk.q, 0); mk.qmax = __builtin_amdgcn_readlane(mk.q, 31);
    LAS float* imp = (LAS float*)lds + 18432;
#pragma unroll
    for (int r = 0; r < 16; ++r) { const int q = slab * 32 + crow(r, hi); imp[(ht * 128 + q) * 64 + r32] = 0.f; imp[(ht * 128 + q) * 64 + 32 + r32] = 0.f; }
#pragma unroll 1
    for (int hh = 0; hh < 3; ++hh) {
        f32x16 oi0 = zero16(), oi1 = zero16();
        const int hq = g * 6 + ht * 3 + hh;
        const bf16* qp = Q + ((size_t)(b * S + t)) * 1536 + hq * 128 + hi * 8;
        bf16x8 qr[8] = {};
        f32x16 o[4] = {zero16(), zero16(), zero16(), zero16()}; float m_reg = -1e30f, l_reg = 0.f;
        attn_stream<1, false>(lds, qr, qp, Kb, Vb, 256, 0, 3, mk, o, m_reg, l_reg, 0.f, oi0, oi1);
        const float inv = l_reg > 0.f ? 1.0f / l_reg : 0.f;
        attn_stream<2, false>(lds, qr, qp, Kb, Vb, 256, 0, 3, mk, o, m_reg, l_reg, inv, oi0, oi1);
        attn_stream<3, false>(lds, qr, qp, Kb, Vb, 256, 0, 3, mk, o, m_reg, l_reg, inv, oi0, oi1);
#pragma unroll
        for (int r = 0; r < 16; ++r) { const int q = slab * 32 + crow(r, hi); imp[(ht * 128 + q) * 64 + r32] += oi0[r]; imp[(ht * 128 + q) * 64 + 32 + r32] += oi1[r]; }
        float f[16]; row_fac(al_l, gates[((size_t)(b * S + t)) * 36 + hq * 3 + 0], r32, hi, f);
        u32x4* Pc = (u32x4*)O + ((size_t)((((b * 2 + g) * 32 + qb) * 6 + ht * 3 + hh) * 4 + slab)) * 512 + lane;
#pragma unroll
        for (int d = 0; d < 4; ++d)
#pragma unroll
            for (int r = 0; r < 16; r += 8) { u32x4 w; w.x = cvtpk(o[d][r] * f[r], o[d][r + 1] * f[r + 1]); w.y = cvtpk(o[d][r + 2] * f[r + 2], o[d][r + 3] * f[r + 3]);
                w.z = cvtpk(o[d][r + 4] * f[r + 4], o[d][r + 5] * f[r + 5]); w.w = cvtpk(o[d][r + 6] * f[r + 6], o[d][r + 7] * f[r + 7]); Pc[(d * 2 + (r >> 3)) * 64] = w; }
    }
    __syncthreads();
    unsigned long long* SEL = (unsigned long long*)(ws + WS_SEL) + (size_t)(b * 2 + g) * S;
#pragma unroll 1
    for (int qi = 0; qi < 16; ++qi) {
        int q = wid * 16 + qi; asm volatile("" : "+v"(q));
        const int tq = qb * 128 + q, cur = tq >> 6, j = lane;
        const float v = imp[q * 64 + j] + imp[(128 + q) * 64 + j];
        const bool forced = (j == 0) || (j == cur) || (j == cur - 1), elig = (j <= cur);
        const float sc = forced ? 1e9f : (elig ? v : -1e9f);
        int cnt = 0;
#pragma unroll 4
        for (int i = 0; i < 64; ++i) { const float other = __uint_as_float(__builtin_amdgcn_readlane(__float_as_uint(sc), i));
            cnt += ((other > sc) || (other == sc && i < j)) ? 1 : 0; }
        const unsigned long long msk = __ballot((cnt < 16) && elig);
        if (lane == 0) SEL[tq] = msk;
    }
    __syncthreads();
}

__device__ __forceinline__ void nsa_main_unit(char* lds, int unit, unsigned char* ws, const float* cmp_part) {
    int tid = threadIdx.x; asm volatile("" : "+v"(tid));
    const int wid = __builtin_amdgcn_readfirstlane(tid >> 6), lane = tid & 63, r32 = lane & 31, hi = lane >> 5;
    const int qb = 31 - unit / 24, rem = unit % 24, b = rem / 6, g = (rem / 3) & 1, hp = rem % 3;
    const int slab = wid & 3, hq = g * 6 + hp * 2 + (wid >> 2);
    const int t = qb * 128 + slab * 32 + r32;
    const bf16* Q = (const bf16*)(ws + WS_OVL + OA_Q); bf16* O = (bf16*)(ws + WS_OVL + OA_O);
    const bf16* KV = (const bf16*)(ws + WS_OVL + OA_KV) + (size_t)(b * S) * 1536;
    const float* gates = (const float*)(ws + WS_GATES) + ((size_t)(b * S + t)) * 36 + hq * 3;
    float* al_l = (float*)(lds + ATT_WS_OFF) + wid * 64;
    const unsigned long long sel = ((const unsigned long long*)(ws + WS_SEL))[(size_t)(b * 2 + g) * S + t];
    bf16x8 qr[8]; load_q(qr, Q + ((size_t)(b * S + t)) * 1536 + hq * 128 + hi * 8);
    const int tmin = __builtin_amdgcn_readlane(t, 0), tmax = __builtin_amdgcn_readlane(t, 31);
    f32x16 dm0, dm1;
    {
        f32x16 o[4] = {zero16(), zero16(), zero16(), zero16()}; float m_reg = -1e30f, l_reg = 0.f;
        MaskBand mk; mk.q = t; mk.W = 512; mk.qmin = tmin; mk.qmax = tmax;
        const int lo = qb * 128 - 511, kt0 = lo <= 0 ? 0 : (lo >> 6);
        attn_stream<0, true>(lds, qr, nullptr, KV + (8 + g) * 128, KV + (10 + g) * 128, 1536, kt0, 2 * qb + 1, mk, o, m_reg, l_reg, 0.f, dm0, dm1);
        float f[16]; row_fac(al_l, l_reg > 0.f ? gates[2] / l_reg : 0.f, r32, hi, f);
        LAS u32x4* wsc = (LAS u32x4*)((LAS unsigned char*)lds + 69632 + tid * 128);
#pragma unroll
        for (int d = 0; d < 4; ++d)
#pragma unroll
            for (int r = 0; r < 16; r += 8) { u32x4 w; w.x = cvtpk(o[d][r] * f[r], o[d][r + 1] * f[r + 1]); w.y = cvtpk(o[d][r + 2] * f[r + 2], o[d][r + 3] * f[r + 3]);
                w.z = cvtpk(o[d][r + 4] * f[r + 4], o[d][r + 5] * f[r + 5]); w.w = cvtpk(o[d][r + 6] * f[r + 6], o[d][r + 7] * f[r + 7]); wsc[d * 2 + (r >> 3)] = w; }
    }
    {
        f32x16 o[4] = {zero16(), zero16(), zero16(), zero16()}; float m_reg = -1e30f, l_reg = 0.f;
        MaskSel mk; mk.q = t; mk.qmin = tmin; mk.qmax = tmax; mk.sel = sel;
        attn_stream<0, true>(lds, qr, nullptr, KV + (4 + g) * 128, KV + (6 + g) * 128, 1536, 0, 2 * qb + 1, mk, o, m_reg, l_reg, 0.f, dm0, dm1);
        float f[16]; row_fac(al_l, l_reg > 0.f ? gates[1] / l_reg : 0.f, r32, hi, f);
        bf16* Ow = O + ((size_t)(b * S + qb * 128 + slab * 32)) * 2048 + hq * 128;
        const u32x4* Pc = (const u32x4*)cmp_part + ((size_t)((((b * 2 + g) * 32 + qb) * 6 + hp * 2 + (wid >> 2)) * 4 + slab)) * 512 + lane;
        u32x4 pc[8];
#pragma unroll
        for (int j = 0; j < 8; ++j) pc[j] = Pc[j * 64];
#pragma unroll
        for (int d = 0; d < 4; ++d)
#pragma unroll
            for (int r = 0; r < 16; r += 8) { const u32x4 w = ((const LAS u32x4*)((LAS unsigned char*)lds + 69632 + tid * 128))[d * 2 + (r >> 3)];
#pragma unroll
                for (int e = 0; e < 4; ++e) { const unsigned pw = pc[d * 2 + (r >> 3)][e];
                    o[d][r + 2 * e] = o[d][r + 2 * e] * f[r + 2 * e] + __uint_as_float(w[e] << 16) + __uint_as_float(pw << 16);
                    o[d][r + 2 * e + 1] = o[d][r + 2 * e + 1] * f[r + 2 * e + 1] + __uint_as_float(w[e] & 0xffff0000u) + __uint_as_float(pw & 0xffff0000u); } }
#pragma unroll
        for (int r = 0; r < 16; ++r) { const int orow = crow(r, hi);
#pragma unroll
            for (int d = 0; d < 4; ++d) { const size_t off = (size_t)orow * 2048 + d * 32 + r32;
                Ow[off] = (bf16)(cvtpk(o[d][r], 0.f) & 0xffffu); } }
    }
}

constexpr size_t OB_PO = OB_O + (size_t)M * 1024 * 2;
static_assert(OB_PO + 3 * (size_t)M * 512 * 2 <= OVL_BYTES, "dilated partials");
__device__ __forceinline__ void dil_unit(char* lds, int unit, unsigned char* ws) {
    int tid = threadIdx.x; asm volatile("" : "+v"(tid));
    const int wid = __builtin_amdgcn_readfirstlane(tid >> 6), lane = tid & 63, r32 = lane & 31, hi = lane >> 5;
    const int gi = unit >> 8, rem = unit & 255, b = rem >> 6, hg = (rem >> 4) & 3;
    const int sh = 2 * gi, nblk = 16 >> sh, blk = rem & (nblk - 1), cls = (rem & 15) >> (4 - sh);
    const int qi = 256 * blk + wid * 32 + r32, t = cls + (qi << sh);
    const bf16* Q = (const bf16*)(ws + WS_OVL + OB_Q); const bf16* KS = (const bf16*)(ws + WS_OVL + OB_KS); const bf16* VS = (const bf16*)(ws + WS_OVL + OB_VS);
    bf16* PO = (bf16*)(ws + WS_OVL + OB_PO) + (size_t)gi * M * 512;
    float* LSE = (float*)(ws + WS_OSCR) + (size_t)gi * M * 4;
    f32x16 o[4] = {zero16(), zero16(), zero16(), zero16()}; float m_reg = -1e30f, l_reg = 0.f; f32x16 dm0, dm1;
    bf16x8 qr[8]; load_q(qr, Q + ((size_t)(b * S + t)) * 1536 + (gi * 4 + hg) * 128 + hi * 8);
    MaskBand mk; mk.q = qi; mk.W = 129; mk.qmin = __builtin_amdgcn_readlane(mk.q, 0); mk.qmax = __builtin_amdgcn_readlane(mk.q, 31);
    const size_t base = ((size_t)(b * S + cls)) * 512 + hg * 128;
    const int kt0 = 4 * blk - 2 < 0 ? 0 : 4 * blk - 2;
    attn_stream<0, true>(lds, qr, nullptr, KS + base, VS + base, (long)512 << sh, kt0, 4 * blk + 3, mk, o, m_reg, l_reg, 0.f, dm0, dm1);
    if (hi == 0) LSE[((size_t)(b * S + t)) * 4 + hg] = m_reg + __builtin_amdgcn_logf(l_reg);
    float f[16]; row_fac((float*)(lds + ATT_WS_OFF) + wid * 64, l_reg > 0.f ? 1.0f / l_reg : 0.f, r32, hi, f);
    bf16* Ow = PO + ((size_t)(b * S + cls + ((256 * blk + wid * 32) << sh))) * 512 + hg * 128;
    const size_t rstride = (size_t)512 << sh;
#pragma unroll
    for (int r = 0; r < 16; ++r) { const int orow = crow(r, hi);
#pragma unroll
        for (int d = 0; d < 4; ++d) Ow[(size_t)orow * rstride + d * 32 + r32] = (bf16)(cvtpk(o[d][r] * f[r], 0.f) & 0xffffu); }
}
__device__ __forceinline__ void dil_merge(unsigned char* ws) {
    const bf16* PO = (const bf16*)(ws + WS_OVL + OB_PO); const float* LSE = (const float*)(ws + WS_OSCR);
    bf16* O = (bf16*)(ws + WS_OVL + OB_O);
    int tm = threadIdx.x; asm volatile("" : "+v"(tm));
    for (int e = blockIdx.x * NTHR + tm; e < M * 64; e += gridDim.x * NTHR) {
        const int tok = e >> 6, c8 = e & 63, hg = c8 >> 4;
        const float l0 = LSE[(size_t)tok * 4 + hg], l1 = LSE[(size_t)M * 4 + (size_t)tok * 4 + hg], l2 = LSE[(size_t)2 * M * 4 + (size_t)tok * 4 + hg];
        const float mx = fmaxf(l0, fmaxf(l1, l2));
        float w0 = __builtin_amdgcn_exp2f(l0 - mx), w1 = __builtin_amdgcn_exp2f(l1 - mx), w2 = __builtin_amdgcn_exp2f(l2 - mx);
        const float inv = 1.0f / (w0 + w1 + w2); w0 *= inv; w1 *= inv; w2 *= inv;
        const u32x4 a = *(const u32x4*)(PO + (size_t)tok * 512 + c8 * 8), bq = *(const u32x4*)(PO + (size_t)M * 512 + (size_t)tok * 512 + c8 * 8), cq = *(const u32x4*)(PO + (size_t)2 * M * 512 + (size_t)tok * 512 + c8 * 8);
        u32x4 r;
#pragma unroll
        for (int i = 0; i < 4; ++i) {
            const float lo = w0 * __uint_as_float(a[i] << 16) + w1 * __uint_as_float(bq[i] << 16) + w2 * __uint_as_float(cq[i] << 16);
            const float hh = w0 * __uint_as_float(a[i] & 0xffff0000u) + w1 * __uint_as_float(bq[i] & 0xffff0000u) + w2 * __uint_as_float(cq[i] & 0xffff0000u);
            r[i] = cvtpk(lo, hh); }
        *(u32x4*)(O + (size_t)tok * 1024 + c8 * 8) = r;
    }
}

__device__ __forceinline__ void compress_unit(char* lds, int unit, unsigned char* ws) {
    int tid = threadIdx.x; asm volatile("" : "+v"(tid));
    const int wid = __builtin_amdgcn_readfirstlane(tid >> 6), lane = tid & 63, r32 = lane & 31, hi = lane >> 5;
    const int kv = unit >> 6, g = (unit >> 5) & 1, mt = unit & 31, b = mt >> 3, c0 = (mt & 7) * 32;
    const bf16* KVp = (const bf16*)(ws + WS_OVL + OA_KV);
    const bf16* W1t = (const bf16*)(ws + (kv ? WS_W1V : WS_W1K));
    const bf16* W2t = (const bf16*)(ws + (kv ? WS_W2V : WS_W2K));
    const float* bias = (const float*)(ws + WS_BIAS) + kv * 256;
    f32x16 acc = zero16();
    const int c = c0 + r32, n = 32 * wid + r32;
    const bf16* bp = W1t + (size_t)n * 4096 + hi * 8;
    bf16x8 fa[2][8], fb[2][8];
#define CLOAD(s_, l_) do { int tok_ = 16 * c + (l_); tok_ = tok_ < S ? tok_ : S - 1; \
        const bf16* ap_ = KVp + ((size_t)(b * S + tok_)) * 1536 + (kv * 2 + g) * 128 + hi * 8; \
        _Pragma("unroll") for (int ks = 0; ks < 8; ++ks) { fa[s_][ks] = *(const bf16x8*)(ap_ + ks * 16); fb[s_][ks] = *(const bf16x8*)(bp + (l_) * 128 + ks * 16); } } while (0)
#define CMMA(s_) do { _Pragma("unroll") for (int ks = 0; ks < 8; ++ks) acc = __builtin_amdgcn_mfma_f32_32x32x16_bf16(fa[s_][ks], fb[s_][ks], acc, 0, 0, 0); } while (0)
    CLOAD(0, 0);
#pragma unroll 1
    for (int l = 0; l < 32; l += 2) {
        CLOAD(1, l + 1);
        CMMA(0);
        if (l + 2 < 32) CLOAD(0, l + 2);
        CMMA(1);
    }
#undef CLOAD
#undef CMMA
    bf16* hid = (bf16*)lds;
    const float bn = bias[n];
#pragma unroll
    for (int r = 0; r < 16; ++r) { const float z = acc[r] + bn; const float sg = z / (1.0f + __expf(-z));
        hid[crow(r, hi) * 264 + n] = (bf16)(cvtpk(sg, 0.f) & 0xffffu); }
    __syncthreads();
#ifdef CX_DUMP_HID
    { bf16* dd = (bf16*)(ws + WS_OSCR) + (size_t)unit * 8192; for (int e = tid; e < 8192; e += NTHR) dd[e] = hid[(e >> 8) * 264 + (e & 255)]; }
#endif
    if (wid < 4) {
        f32x16 a2 = zero16();
        const int n2 = 32 * wid + r32;
#pragma unroll
        for (int ks = 0; ks < 16; ++ks) {
            const bf16x8 a = *(const bf16x8*)(hid + r32 * 264 + ks * 16 + hi * 8), bb = *(const bf16x8*)(W2t + (size_t)n2 * 256 + ks * 16 + hi * 8);
            a2 = __builtin_amdgcn_mfma_f32_32x32x16_bf16(a, bb, a2, 0, 0, 0);
        }
        bf16* outp = (bf16*)(ws + (kv ? WS_VC : WS_KC));
#pragma unroll
        for (int r = 0; r < 16; ++r) { const int cc = c0 + crow(r, hi);
            outp[((size_t)(b * 256 + cc) * 2 + g) * 128 + n2] = (cc == 255) ? (bf16)0 : (bf16)(cvtpk(a2[r], 0.f) & 0xffffu); }
    }
    __syncthreads();
}

__global__ void __launch_bounds__(NTHR) fwd_kernel(Params p) {
    extern __shared__ __attribute__((aligned(16))) unsigned char lds[];
    unsigned char* ws = p.ws;
    const int tid = threadIdx.x;
    unsigned* ctl = (unsigned*)(ws + WS_CTL);
    for (int sq_ = p.ph_lo; sq_ < p.ph_hi; ++sq_) {
        const int ph = sq_ <= 9 ? sq_ : (sq_ == 10 ? 14 : sq_ - 1);
        const int rep = 0;
        const bool is_gemm = (PH_MASK & 1) && ((ph == 1) || (ph >= 5 && ph <= 8) || (ph >= 10 && ph <= 12));
        if (is_gemm) {
            const int ngem = (ph == 1) ? 3 : 1;
            for (int gi = 0; gi < ngem; ++gi) {
                pg8::Gemm g; pg8::EpiG E; int corder = (int)blockIdx.x;
                E.mode = 0; E.ss = nullptr; E.ssq = nullptr; E.res = nullptr; E.resb = nullptr; E.hout = nullptr; E.hb = nullptr; E.ssout = nullptr; E.o0 = E.o1 = E.o2 = E.o3 = nullptr;
                E.gates = nullptr; E.gbias = nullptr; E.cosT = (const float*)(ws + WS_COS); E.sinT = (const float*)(ws + WS_SIN);
                const pg8::bf16_t* HBp = (const pg8::bf16_t*)(ws + WS_HB);
                if (ph == 1 && gi == 0) {
                    g = pg8::Gemm{HBp, (const pg8::bf16_t*)(ws + WS_WINA), M, 3840, 2048};
                    E.mode = pg8::EM_INA; E.ss = (const float*)(ws + WS_SS0); E.o0 = (pg8::bf16_t*)(ws + WS_OVL + OA_Q); E.o1 = (pg8::bf16_t*)(ws + WS_OVL + OA_KV); E.o2 = (pg8::bf16_t*)(ws + WS_OVL + OA_ZM);
                    E.gates = (float*)(ws + WS_GATES); E.gbias = p.in[4];
                } else if (ph == 1) {
                    g = pg8::Gemm{(const pg8::bf16_t*)(ws + WS_MEMB), (const pg8::bf16_t*)(ws + (gi == 1 ? WS_WMEMA : WS_WMEMB)), 1024, 1024, 2048};
                    E.mode = pg8::EM_MEMKV; E.ss = (const float*)(ws + WS_SSMEM); E.o0 = (pg8::bf16_t*)(ws + (gi == 1 ? WS_MKVA : WS_MKVB));
                    corder = ((int)blockIdx.x + (int)gridDim.x - (gi == 1 ? 192 : 208)) % (int)gridDim.x;
                } else if (ph == 5) {
                    g = pg8::Gemm{(const pg8::bf16_t*)(ws + WS_OVL + OA_O), (const pg8::bf16_t*)(ws + WS_WOA), M, 2048, 2048};
                    E.mode = pg8::EM_RES; E.resb = (const pg8::bf16_t*)(ws + WS_HB); E.hout = nullptr; E.hb = (pg8::bf16_t*)(ws + WS_HB); E.ssout = (unsigned long long*)(ws + WS_CTL + CTL_SS1);
                } else if (ph == 6 || ph == 11) {
                    g = pg8::Gemm{HBp, (const pg8::bf16_t*)(ws + (ph == 6 ? WS_WGUA : WS_WGUB)), M, 11264, 2048};
                    E.mode = pg8::EM_GU; E.ssq = (const unsigned long long*)(ws + WS_CTL + (ph == 6 ? CTL_SS1 : CTL_SS3)); E.o0 = (pg8::bf16_t*)(ws + WS_OVL);
                } else if (ph == 7 || ph == 12) {
                    g = pg8::Gemm{(const pg8::bf16_t*)(ws + WS_OVL), (const pg8::bf16_t*)(ws + (ph == 7 ? WS_WDA : WS_WDB)), M, 2048, 5632};
                    E.mode = pg8::EM_RES; E.resb = (const pg8::bf16_t*)(ws + WS_HB); E.hout = nullptr; E.hb = (pg8::bf16_t*)(ws + WS_HB); E.ssout = (unsigned long long*)(ws + WS_CTL + (ph == 7 ? CTL_SS2 : CTL_SS4));
                } else if (ph == 8) {
                    g = pg8::Gemm{HBp, (const pg8::bf16_t*)(ws + WS_WINB), M, 3072, 2048};
                    E.mode = pg8::EM_INB; E.ssq = (const unsigned long long*)(ws + WS_CTL + CTL_SS2); E.o0 = (pg8::bf16_t*)(ws + WS_OVL + OB_Q); E.o2 = (pg8::bf16_t*)(ws + WS_OVL + OB_ZM);
                    E.o1 = (pg8::bf16_t*)(ws + WS_OVL + OB_KS); E.o3 = (pg8::bf16_t*)(ws + WS_OVL + OB_VS);
                } else {
                    g = pg8::Gemm{(const pg8::bf16_t*)(ws + WS_OVL + OB_O), (const pg8::bf16_t*)(ws + WS_WOB), M, 2048, 1024};
                    E.mode = pg8::EM_RES; E.resb = (const pg8::bf16_t*)(ws + WS_HB); E.hout = nullptr; E.hb = (pg8::bf16_t*)(ws + WS_HB); E.ssout = (unsigned long long*)(ws + WS_CTL + CTL_SS3);
                }
                pg8::StaticOrder So; So.init(g.M, g.N, (int)gridDim.x, corder);
                pg8::gemm_phase<pg8::EpiG, pg8::StaticOrder, true, true>((LAS unsigned char*)lds, g, So, E);
                __syncthreads();
            }
        } else if ((PH_MASK & 2) && ph == 0) {
            phase_prologue(p, lds);
        } else if ((PH_MASK & 4) && ph == 2) {
            for (int u = blockIdx.x; u < 128; u += gridDim.x) compress_unit((char*)lds, u, ws);
            for (;;) { const int u = next_unit((char*)lds, ctl + 192); if (u >= 256) break;
                mem_attn_unit((char*)lds, u, (const bf16*)(ws + WS_OVL + OA_ZM), (const bf16*)(ws + WS_MKVA), (bf16*)(ws + WS_OVL + OA_O), 2048, 1536); }
        } else if ((PH_MASK & 8) && ph == 3) {
            for (;;) { const int u = next_unit((char*)lds, ctl + 0 + rep); if (u >= 256) break; nsa_cmp_unit((char*)lds, u, ws, p.out); }
        } else if ((PH_MASK & 16) && ph == 4) {
            for (;;) { const int u = next_unit((char*)lds, ctl + 64 + rep); if (u >= 768) break; nsa_main_unit((char*)lds, u, ws, p.out); }
        } else if ((PH_MASK & 32) && ph == 9) {
            for (;;) { const int u = next_unit((char*)lds, ctl + 128 + rep); if (u >= 1024) break;
                if (u < 768) dil_unit((char*)lds, u, ws);
                else mem_attn_unit((char*)lds, u - 768, (const bf16*)(ws + WS_OVL + OB_ZM), (const bf16*)(ws + WS_MKVB), (bf16*)(ws + WS_OVL + OB_O), 1024, 512); }
        } else if (ph == 14) {
            dil_merge(ws);
        } else if ((PH_MASK & 64) && ph == 13) {
            int tl = threadIdx.x; asm volatile("" : "+v"(tl));
            const int lane = tl & 63, gw = blockIdx.x * 8 + (tl >> 6), NGW = gridDim.x * 8;
            const unsigned long long* ss4 = (const unsigned long long*)(ws + WS_CTL + CTL_SS4); const f32x4* gn = (const f32x4*)p.in[29] + lane;
            for (int m = gw; m < M; m += NGW) {
                const float rs = 1.0f / sqrtf((float)ss4[m] * 5.9604644775390625e-08f * (1.0f / 2048.0f) + 1e-6f);
                f32x4* xr = (f32x4*)(p.out + (size_t)m * DM) + lane;
                const u32x2v* hr = (const u32x2v*)((const bf16*)(ws + WS_HB) + (size_t)m * DM) + lane;
#pragma unroll
                for (int j = 0; j < 8; ++j) { const u32x2v w = hr[64 * j];
                    const f32x4 v = {__uint_as_float(w.x << 16), __uint_as_float(w.x & 0xffff0000u), __uint_as_float(w.y << 16), __uint_as_float(w.y & 0xffff0000u)};
                    xr[64 * j] = v * rs * gn[64 * j]; }
            }
        }
        if (sq_ + 1 < p.ph_hi) {
            asm volatile("s_waitcnt vmcnt(0) lgkmcnt(0)" ::: "memory");
            cg::this_grid().sync();
            __builtin_amdgcn_fence(__ATOMIC_ACQUIRE, "agent");
            asm volatile("s_waitcnt vmcnt(0)" ::: "memory");
        }
    }
}

#ifndef DBG_DUMP_N
#define DBG_DUMP_N (M * DM)
#endif
__global__ void __launch_bounds__(256) dbg_dump(const unsigned short* src, float* out, size_t n) {
    for (size_t i = (size_t)blockIdx.x * 256 + threadIdx.x; i < n; i += (size_t)gridDim.x * 256) { float v = bf2f(src[i % (size_t)(DBG_DUMP_N)]); if (!(fabsf(v) < 1e30f)) v = 12345.f; out[i] = v; }
}
extern "C" void kernel_launch(void* const* d_in, const int* in_sizes, int n_in, void* d_out, int out_size, void* d_ws, size_t ws_size, hipStream_t stream) {
    static int grid = 0;
    if (grid == 0) {
        if (n_in != 30 || in_sizes[0] != M * DM || out_size != M * DM || ws_size < WS_END) {
            fprintf(stderr, "kernel_launch: unexpected shapes: n_in %d in0 %d out %d ws %zu (need %zu)\n", n_in, n_in > 0 ? in_sizes[0] : -1, out_size, ws_size, (size_t)WS_END); grid = -1; return; }
        int dev = 0, cus = 0, per_cu = 0;
        if (hipGetDevice(&dev) != hipSuccess || hipDeviceGetAttribute(&cus, hipDeviceAttributeMultiprocessorCount, dev) != hipSuccess) { grid = -1; return; }
        if (hipFuncSetAttribute((const void*)fwd_kernel, hipFuncAttributeMaxDynamicSharedMemorySize, LDS_BYTES) != hipSuccess) { fprintf(stderr, "kernel_launch: hipFuncSetAttribute failed\n"); grid = -1; return; }
        if (hipOccupancyMaxActiveBlocksPerMultiprocessor(&per_cu, (const void*)fwd_kernel, NTHR, LDS_BYTES) != hipSuccess || per_cu < 1) { fprintf(stderr, "kernel_launch: occupancy query says %d\n", per_cu); per_cu = 1; }
        (void)hipGetLastError();
        grid = cus;
    }
    if (grid < 0) return;
    (void)hipMemsetAsync((char*)d_ws + WS_CTL, 0, CTL_BYTES, stream);
    Params prm{};
    for (int i = 0; i < 30; ++i) prm.in[i] = (const float*)d_in[i];
    prm.out = (float*)d_out; prm.ws = (unsigned char*)d_ws;
#if N_LAUNCH_MODE == 1
    prm.ph_lo = 0; prm.ph_hi = NPH + 1;
    void* args[] = {&prm};
    hipError_t e = hipLaunchCooperativeKernel((const void*)fwd_kernel, dim3(grid), dim3(NTHR), args, LDS_BYTES, stream);
    if (e != hipSuccess) fprintf(stderr, "kernel_launch: cooperative launch failed: %s (grid %d)\n", hipGetErrorString(e), grid);
#else
#ifndef DBG_STOP
#define DBG_STOP (NPH)
#endif
    for (int ph = 0; ph <= DBG_STOP; ++ph) {
        prm.ph_lo = ph; prm.ph_hi = ph + 1;
        hipLaunchKernelGGL(fwd_kernel, dim3(grid), dim3(NTHR), LDS_BYTES, stream, prm);
    }
#ifdef DBG_DUMP_OFF
    hipLaunchKernelGGL(dbg_dump, dim3(2048), dim3(256), 0, stream, (const unsigned short*)((unsigned char*)d_ws + (DBG_DUMP_OFF)), (float*)d_out, (size_t)M * DM);
#endif
    hipError_t e = hipPeekAtLastError();
    if (e != hipSuccess) fprintf(stderr, "kernel_launch: launch failed: %s\n", hipGetErrorName(e));
#endif
}
```
